# Optimizing an MI355X kernel written in HIP

```python
import math
import jax, jax.numpy as jnp
from jax import lax
import numpy as np

D_MODEL = 1024
BATCH = 2
SEQ = 8192
DEPTH = 2

GRID_W = 64
CTX_LEN = 256
FOURIER_W = D_MODEL // 4
FOURIER_GC = 64
FOURIER_GROUPS = FOURIER_W // FOURIER_GC
DIFF_HD = 64
DIFF_VD = 2 * DIFF_HD
DIFF_HEADS = (D_MODEL - FOURIER_W) // DIFF_VD
QK_W = DIFF_HEADS * 2 * DIFF_HD
V_W = DIFF_HEADS * DIFF_VD
EVEN_IN_W = FOURIER_W + 2 * QK_W + V_W
DIFF_SCALE = DIFF_HD ** -0.5
Q_BLOCK = 128
ROPE_BASE = 10000.0
ROPE_FREQS = DIFF_HD // 4
S5_W = D_MODEL // 2
S5_GC = 16
S5_GROUPS = S5_W // S5_GC
S5_STATE = 64
GMLP_W = D_MODEL // 2
GMLP_GC = 128
GMLP_GROUPS = GMLP_W // GMLP_GC
CHUNK = 128
ODD_IN_W = S5_W + 2 * GMLP_W
MIX_W = D_MODEL
FFN_W = 4 * D_MODEL
LN_EPS = 1e-5
ALPHA = (2 * DEPTH) ** 0.25
BETA = (8 * DEPTH) ** -0.25
N_EVEN = (DEPTH + 1) // 2
N_ODD = DEPTH // 2

kernel_name = 'hybrid_fourier_diffattn_s5_gmlp_diffusion_trunk'


def _layernorm(x):
    xf = x.astype(jnp.float32)
    xc = xf - jnp.mean(xf, -1, keepdims=True)
    var = jnp.mean(xc * xc, -1, keepdims=True)
    return (xc * lax.rsqrt(var + LN_EPS)).astype(x.dtype)


def _modulate(x, shift, scale):
    return _layernorm(x) * (1 + scale) + shift


def _post_norm(x, y, gate, g, b):
    return _layernorm(ALPHA * x + gate * y) * g + b


def _axial_rope_tables(n):
    rows = n // GRID_W
    row = jnp.repeat(jnp.arange(rows, dtype=jnp.float32), GRID_W)
    col = jnp.tile(jnp.arange(GRID_W, dtype=jnp.float32), rows)
    inv = jnp.power(ROPE_BASE, -jnp.arange(ROPE_FREQS, dtype=jnp.float32) / ROPE_FREQS)
    ang = jnp.stack([row[:, None] * inv, col[:, None] * inv], axis=1)
    return jnp.cos(ang), jnp.sin(ang)


def _apply_rope(t, cos, sin):
    sh = t.shape
    tr = t.reshape(sh[:-1] + (2, 2, ROPE_FREQS))
    c = cos[None, :, None, None].astype(t.dtype)
    s = sin[None, :, None, None].astype(t.dtype)
    t1 = tr[..., 0, :]
    t2 = tr[..., 1, :]
    out = jnp.stack([t1 * c - t2 * s, t2 * c + t1 * s], axis=-2)
    return out.reshape(sh)


def _fourier_mix(f):
    B, L, _ = f.shape
    fg = f.astype(jnp.float32).reshape(B, L, FOURIER_GROUPS, FOURIER_GC)
    out = jnp.fft.fft2(fg, axes=(1, 3), norm='ortho').real
    return out.reshape(B, L, FOURIER_W).astype(f.dtype)


def _diff_attend(q, k_all, v_all, lam):
    s = jnp.einsum('bqhcd,bkhcd->bhcqk', q, k_all).astype(jnp.float32) * DIFF_SCALE
    p = jax.nn.softmax(s, axis=-1)
    a = p[:, :, 0] - lam * p[:, :, 1]
    return jnp.einsum('bhqk,bkhe->bqhe', a.astype(v_all.dtype), v_all)


def _diff_post(o, subln_g, lam_init):
    of = o.astype(jnp.float32)
    of = of * lax.rsqrt(jnp.mean(of * of, -1, keepdims=True) + LN_EPS)
    out = of.astype(o.dtype) * subln_g * (1 - lam_init)
    return out.reshape(o.shape[0], o.shape[1], V_W)


def _even_mixer(h, hc, w_in, lam_q1, lam_k1, lam_q2, lam_k2, subln_g, cos, sin, layer_idx, need_ctx):
    B, L, _ = h.shape
    Lc = hc.shape[1]
    kv0 = FOURIER_W + QK_W
    z = h @ w_in
    f = z[..., :FOURIER_W]
    q = z[..., FOURIER_W:kv0].reshape(B, L, DIFF_HEADS, 2, DIFF_HD)
    k = z[..., kv0:kv0 + QK_W].reshape(B, L, DIFF_HEADS, 2, DIFF_HD)
    v = z[..., kv0 + QK_W:].reshape(B, L, DIFF_HEADS, DIFF_VD)
    if need_ctx:
        zc = hc @ w_in
        fc = zc[..., :FOURIER_W]
        qc = zc[..., FOURIER_W:kv0].reshape(B, Lc, DIFF_HEADS, 2, DIFF_HD)
        zc_kv = zc[..., kv0:]
    else:
        zc_kv = hc @ w_in[:, kv0:]
    kc = zc_kv[..., :QK_W].reshape(B, Lc, DIFF_HEADS, 2, DIFF_HD)
    vc = zc_kv[..., QK_W:].reshape(B, Lc, DIFF_HEADS, DIFF_VD)
    lam_init = 0.8 - 0.6 * math.exp(-0.3 * layer_idx)
    f32 = jnp.float32
    lam = (jnp.exp(jnp.sum(lam_q1.astype(f32) * lam_k1.astype(f32)))
           - jnp.exp(jnp.sum(lam_q2.astype(f32) * lam_k2.astype(f32))) + lam_init)
    q = _apply_rope(q, cos, sin)
    k = _apply_rope(k, cos, sin)
    k_all = jnp.concatenate([kc, k], axis=1)
    v_all = jnp.concatenate([vc, v], axis=1)
    nb = L // Q_BLOCK
    qb = jnp.moveaxis(q.reshape(B, nb, Q_BLOCK, DIFF_HEADS, 2, DIFF_HD), 1, 0)
    o = lax.map(lambda qi: _diff_attend(qi, k_all, v_all, lam), qb)
    o = jnp.moveaxis(o, 0, 1).reshape(B, L, DIFF_HEADS, DIFF_VD)
    y = jnp.concatenate([_fourier_mix(f), _diff_post(o, subln_g, lam_init)], axis=-1)
    if need_ctx:
        oc = _diff_attend(qc, kc, vc, lam)
        yc = jnp.concatenate([_fourier_mix(fc), _diff_post(oc, subln_g, lam_init)], axis=-1)
    else:
        yc = None
    return y, yc


def _lin_recur(left, right):
    a_l, b_l = left
    a_r, b_r = right
    return a_r * a_l, a_r * b_l + b_r


def _s5_drive(u, bbar):
    B, L, _ = u.shape
    ug = u.astype(jnp.float32).reshape(B, L, S5_GROUPS, S5_GC).astype(jnp.complex64)
    return jnp.einsum('bsgi,gpi->bsgp', ug, bbar)


def _s5_scan(bu, lam_bar, h0, reverse):
    if h0 is not None:
        idx = -1 if reverse else 0
        bu = bu.at[:, idx].add(lam_bar * h0)
    a = jnp.broadcast_to(lam_bar, bu.shape)
    _, hs = lax.associative_scan(_lin_recur, (a, bu), reverse=reverse, axis=1)
    return hs


def _s5_mixer(s, sc, lam_re, lam_im, log_dt, b_re, b_im, c_re, c_im, d_skip, w_glu, b_glu, need_ctx):
    f32 = jnp.float32
    B, L, _ = s.shape
    Lc = sc.shape[1]
    lam = lax.complex(lam_re.astype(f32), lam_im.astype(f32))
    dt = jnp.exp(log_dt.astype(f32))[..., None]
    lam_bar = jnp.exp(lam * dt)
    bbar = ((lam_bar - 1) / lam)[..., None] * lax.complex(b_re.astype(f32), b_im.astype(f32))
    cmat = lax.complex(c_re.astype(f32), c_im.astype(f32))
    d = d_skip.astype(f32)
    y = d * s.astype(f32)
    yc = d * sc.astype(f32) if need_ctx else None
    for r, rev in enumerate((False, True)):
        hs_c = _s5_scan(_s5_drive(sc, bbar[r]), lam_bar[r], None, rev)
        h0 = hs_c[:, 0] if rev else hs_c[:, -1]
        hs = _s5_scan(_s5_drive(s, bbar[r]), lam_bar[r], h0, rev)
        y = y + jnp.einsum('bsgp,gip->bsgi', hs, cmat[r]).real.reshape(B, L, S5_W)
        if need_ctx:
            yc = yc + jnp.einsum('bsgp,gip->bsgi', hs_c, cmat[r]).real.reshape(B, Lc, S5_W)
    wg = w_glu.astype(f32)
    bg = b_glu.astype(f32)

    def glu(t):
        g = jax.nn.gelu(t)
        return (g * jax.nn.sigmoid(g @ wg + bg)).astype(s.dtype)

    return glu(y), (glu(yc) if need_ctx else None)


def _chunk_gmlp(u, v, w_sp, b_sp):
    B, L, _ = u.shape
    n = L // CHUNK
    vg = _layernorm(v.reshape(B, n, CHUNK, GMLP_GROUPS, GMLP_GC))
    sp = jnp.einsum('gpq,bnqgc->bnpgc', w_sp, vg) + jnp.swapaxes(b_sp, 0, 1)[:, :, None]
    return (u.reshape(B, n, CHUNK, GMLP_GROUPS, GMLP_GC) * sp).reshape(B, L, GMLP_W)


def _odd_mixer(h, hc, w_in, lam_re, lam_im, log_dt, b_re, b_im, c_re, c_im, d_skip, w_glu, b_glu,
               w_sp, b_sp, need_ctx):
    z = h @ w_in
    s = z[..., :S5_W]
    u = z[..., S5_W:S5_W + GMLP_W]
    v = z[..., S5_W + GMLP_W:]
    if need_ctx:
        zc = hc @ w_in
        sc = zc[..., :S5_W]
        uc = zc[..., S5_W:S5_W + GMLP_W]
        vc = zc[..., S5_W + GMLP_W:]
    else:
        sc = hc @ w_in[:, :S5_W]
    ys, ysc = _s5_mixer(s, sc, lam_re, lam_im, log_dt, b_re, b_im, c_re, c_im, d_skip, w_glu, b_glu, need_ctx)
    y = jnp.concatenate([ys, _chunk_gmlp(u, v, w_sp, b_sp)], axis=-1)
    yc = jnp.concatenate([ysc, _chunk_gmlp(uc, vc, w_sp, b_sp)], axis=-1) if need_ctx else None
    return y, yc


def _sq_relu_mlp(h, w1, b1, w2, b2):
    a = jax.nn.relu(h @ w1 + b1)
    return (a * a) @ w2 + b2


def setup_inputs(seed: int = 0) -> dict:
    key = jax.random.key(seed)
    ks = iter(jax.random.split(key, 40))
    f32 = jnp.float32
    D = D_MODEL

    def nrm(shape, s):
        return jax.random.normal(next(ks), shape, f32) * s

    lam_im_base = jnp.broadcast_to(jnp.pi * jnp.arange(S5_STATE, dtype=f32), (N_ODD, 2, S5_GROUPS, S5_STATE))
    return {
        'x': nrm((BATCH, SEQ, D), 1.0),
        'c': nrm((BATCH, D), 1.0),
        'ctx': nrm((BATCH, CTX_LEN, D), 1.0),
        'c_ctx': nrm((D,), 1.0),
        'w_mod': nrm((DEPTH, D, 6 * D), D ** -0.5),
        'b_mod': nrm((DEPTH, 6 * D), 0.01),
        'w_out': nrm((DEPTH, MIX_W, D), BETA * MIX_W ** -0.5),
        'b_out': nrm((DEPTH, D), 0.01),
        'ln_mix_g': 1.0 + nrm((DEPTH, D), 0.01),
        'ln_mix_b': nrm((DEPTH, D), 0.01),
        'w_ffn1': nrm((DEPTH, D, FFN_W), D ** -0.5),
        'b_ffn1': nrm((DEPTH, FFN_W), 0.01),
        'w_ffn2': nrm((DEPTH, FFN_W, D), BETA * FFN_W ** -0.5),
        'b_ffn2': nrm((DEPTH, D), 0.01),
        'ln_ffn_g': 1.0 + nrm((DEPTH, D), 0.01),
        'ln_ffn_b': nrm((DEPTH, D), 0.01),
        'w_in_ab': nrm((N_EVEN, D, EVEN_IN_W), D ** -0.5),
        'lam_q1': nrm((N_EVEN, DIFF_HD), 0.1),
        'lam_k1': nrm((N_EVEN, DIFF_HD), 0.1),
        'lam_q2': nrm((N_EVEN, DIFF_HD), 0.1),
        'lam_k2': nrm((N_EVEN, DIFF_HD), 0.1),
        'subln_g': 1.0 + nrm((N_EVEN, DIFF_VD), 0.01),
        'w_in_cd': nrm((N_ODD, D, ODD_IN_W), D ** -0.5),
        's5_lam_re': -0.5 + nrm((N_ODD, 2, S5_GROUPS, S5_STATE), 0.01),
        's5_lam_im': lam_im_base + nrm((N_ODD, 2, S5_GROUPS, S5_STATE), 0.01),
        's5_log_dt': jax.random.uniform(next(ks), (N_ODD, 2, S5_GROUPS), f32, math.log(1e-3), math.log(1e-1)),
        's5_b_re': nrm((N_ODD, 2, S5_GROUPS, S5_STATE, S5_GC), (2 * S5_GC) ** -0.5),
        's5_b_im': nrm((N_ODD, 2, S5_GROUPS, S5_STATE, S5_GC), (2 * S5_GC) ** -0.5),
        's5_c_re': nrm((N_ODD, 2, S5_GROUPS, S5_GC, S5_STATE), S5_STATE ** -0.5),
        's5_c_im': nrm((N_ODD, 2, S5_GROUPS, S5_GC, S5_STATE), S5_STATE ** -0.5),
        's5_d': nrm((N_ODD, S5_W), 1.0),
        'w_glu': nrm((N_ODD, S5_W, S5_W), S5_W ** -0.5),
        'b_glu': nrm((N_ODD, S5_W), 0.01),
        'w_sp': nrm((N_ODD, GMLP_GROUPS, CHUNK, CHUNK), CHUNK ** -0.5),
        'b_sp': 1.0 + nrm((N_ODD, GMLP_GROUPS, CHUNK), 0.01),
    }


def reference(x, c, ctx, c_ctx, w_mod, b_mod, w_out, b_out, ln_mix_g, ln_mix_b, w_ffn1, b_ffn1, w_ffn2,
              b_ffn2, ln_ffn_g, ln_ffn_b, w_in_ab, lam_q1, lam_k1, lam_q2, lam_k2, subln_g, w_in_cd,
              s5_lam_re, s5_lam_im, s5_log_dt, s5_b_re, s5_b_im, s5_c_re, s5_c_im, s5_d, w_glu, b_glu,
              w_sp, b_sp):
    L = x.shape[1]
    cos, sin = _axial_rope_tables(L)
    xc = ctx
    for l in range(DEPTH):
        last = l == DEPTH - 1
        e = l // 2
        mod = jax.nn.silu(c) @ w_mod[l] + b_mod[l]
        modc = jax.nn.silu(c_ctx) @ w_mod[l] + b_mod[l]
        sh1, sc1, g1, sh2, sc2, g2 = jnp.split(mod[:, None, :], 6, axis=-1)
        shc1, scc1, gc1, shc2, scc2, gc2 = jnp.split(modc, 6, axis=-1)
        h = _modulate(x, sh1, sc1)
        hc = _modulate(xc, shc1, scc1)
        if l % 2 == 0:
            y, yc = _even_mixer(h, hc, w_in_ab[e], lam_q1[e], lam_k1[e], lam_q2[e], lam_k2[e], subln_g[e],
                                cos, sin, l, not last)
        else:
            y, yc = _odd_mixer(h, hc, w_in_cd[e], s5_lam_re[e], s5_lam_im[e], s5_log_dt[e], s5_b_re[e],
                               s5_b_im[e], s5_c_re[e], s5_c_im[e], s5_d[e], w_glu[e], b_glu[e],
                               w_sp[e], b_sp[e], not last)
        x = _post_norm(x, y @ w_out[l] + b_out[l], g1, ln_mix_g[l], ln_mix_b[l])
        x = _post_norm(x, _sq_relu_mlp(_modulate(x, sh2, sc2), w_ffn1[l], b_ffn1[l], w_ffn2[l], b_ffn2[l]),
                       g2, ln_ffn_g[l], ln_ffn_b[l])
        if not last:
            xc = _post_norm(xc, yc @ w_out[l] + b_out[l], gc1, ln_mix_g[l], ln_mix_b[l])
            xc = _post_norm(xc, _sq_relu_mlp(_modulate(xc, shc2, scc2), w_ffn1[l], b_ffn1[l], w_ffn2[l],
                                             b_ffn2[l]), gc2, ln_ffn_g[l], ln_ffn_b[l])
    return x
```

```cpp
#include <hip/hip_runtime.h>
#include <hip/hip_cooperative_groups.h>
#include <cstdio>
#include <cstdint>
#include <type_traits>
namespace cg = cooperative_groups;
#ifndef MK_MULTI
#define MK_MULTI 0
#endif
#ifndef REP_ATT
#define REP_ATT 1
#endif
#ifndef REP_S5
#define REP_S5 1
#endif
#ifndef REP_G3
#define REP_G3 1
#endif
#ifndef REP_FFN1
#define REP_FFN1 1
#endif
#ifndef REP_P01
#define REP_P01 1
#endif
#ifndef REP_FFT
#define REP_FFT 1
#endif
#ifndef REP_GMLP
#define REP_GMLP 1
#endif
#ifndef REP_SYNC
#define REP_SYNC 1
#endif
#ifndef PROBE_ATT_VAR
#define PROBE_ATT_VAR -1
#endif
#ifndef REP_LN2
#define REP_LN2 1
#endif
namespace pg8 {
#define PG8_LAS __attribute__((address_space(3)))
typedef unsigned short bf16_t;
typedef short bf16x8 __attribute__((ext_vector_type(8)));
typedef float f32x4 __attribute__((ext_vector_type(4)));
typedef unsigned u32x4 __attribute__((ext_vector_type(4)));
constexpr int BM = 256, BK = 64, HALF = 128, HTB = HALF * BK * 2  , STAGE_BYTES = 8 * HTB, NXCD = 8, WGM = 2;

__host__ __device__ __forceinline__ int lds_byte(int r, int c) { const int st = (r >> 4) * 2 + (c >> 5), rr = r & 15, cc = c & 31, ob = rr * 64 + cc * 2; return st * 1024 + (ob ^ (((ob >> 9) & 1) << 5)); }
__host__ __device__ __forceinline__ void stage_rc(int b, int& R, int& C) { const int st = b / 1024, sb = b % 1024, swz = sb ^ (((sb >> 9) & 1) << 5); R = (st >> 1) * 16 + swz / 64; C = (st & 1) * 32 + (swz % 64) / 2; }
__host__ __device__ __forceinline__ int perm32(int rho) { const int n = rho >> 4, i = rho & 15; return 8 * (i >> 2) + 4 * n + (i & 3); }

struct Unit { int pm, pn; int k0 = 0, nt = 0, atomic = 0; };
struct Gemm { const bf16_t* A; const bf16_t* Bt; int M, N, K; };

struct StaticOrder {
    int nM, nN, nwg, G, c;
    __host__ __device__ void init(int M, int N, int G_, int c_) { nM = M / BM; nN = N / BM; nwg = nM * nN; G = G_; c = c_; }
    __host__ __device__ bool next(int i, Unit& u) const {
        const long L = (long)i * G + c; if (L >= nwg) return false;
        int wgid = (int)L; { const int q = nwg / NXCD, r = nwg % NXCD, xcd = wgid % NXCD, off = wgid / NXCD; wgid = (xcd < r ? xcd * (q + 1) : r * (q + 1) + (xcd - r) * q) + off; }
        const int nig = WGM * nN, gid = wgid / nig, fm = gid * WGM, gsz = (nM - fm) < WGM ? (nM - fm) : WGM;
        u.pm = fm + ((wgid % nig) % gsz); u.pn = (wgid % nig) / gsz; return true;
    }
    __device__ __forceinline__ void a_ready(const Unit&) const {}
    __device__ __forceinline__ void done(const Unit&) const {}
};

__device__ __forceinline__ unsigned cvt_pk_bf16(float lo, float hi) { unsigned r; asm volatile("v_cvt_pk_bf16_f32 %0, %1, %2" : "=v"(r) : "v"(lo), "v"(hi)); return r; }
struct SplitOrder {
    StaticOrder base; int G, c, nN, nsplit, kslice, nctx;
    __host__ __device__ void init(int Mx, int N, int K, int G_, int c_, int ctx_tiles_m, int nsplit_) { base.init(Mx, N, G_, c_); G = G_; c = c_; nN = N / BM; nsplit = nsplit_; kslice = K / nsplit_; nctx = ctx_tiles_m * nN * nsplit_; }
    __host__ __device__ bool next(int i, Unit& u) const {
        const long L = (long)i * G + c;
        if (L < base.nwg) { const bool ok = base.next(i, u); u.k0 = 0; u.nt = 0; u.atomic = 0; return ok; }
        const int j = (int)(L - base.nwg); if (j >= nctx) return false;
        const int kp = j % nsplit, t = j / nsplit;
        u.pn = t % nN; u.pm = base.nM + t / nN; u.k0 = kp * kslice; u.nt = kslice / BK; u.atomic = 1; return true;
    }
    __device__ __forceinline__ void a_ready(const Unit&) const {}
    __device__ __forceinline__ void done(const Unit&) const {}
};

constexpr int MX = 16384;
constexpr int NKEY = 8448;
typedef __bf16 bf16x2_t __attribute__((ext_vector_type(2)));
typedef float f32x2_t __attribute__((ext_vector_type(2)));
__device__ __forceinline__ unsigned pk_bf16(float lo, float hi) { f32x2_t v = {lo, hi}; bf16x2_t b = __builtin_convertvector(v, bf16x2_t); return __builtin_bit_cast(unsigned, b); }
__device__ __forceinline__ unsigned short bf16_1(float x) { return (unsigned short)(pk_bf16(x, 0.f) & 0xffffu); }
typedef unsigned u32x2 __attribute__((ext_vector_type(2)));

struct EpiInL0 {
    static constexpr bool PERM = false, AFTER_DRAIN = false;
    float* FG; bf16_t* Q; bf16_t* Kb; bf16_t* Vt; const float* ropeC; const float* ropeS; float qscale;
    __device__ __forceinline__ void operator()(const f32x4 (&acc)[2][2][4][2], const Unit& u, int wr, int wc, int fr, int fq) const {
        const int pn = u.pn;
#pragma unroll
        for (int ai = 0; ai < 2; ++ai)
#pragma unroll
            for (int m = 0; m < 4; ++m) {
                const int row = u.pm * BM + ai * HALF + wr * 64 + m * 16 + fr;
                const bool isx = row < MX;
                const int b = isx ? (row >> 13) : ((row - MX) >> 8), n = isx ? (row & 8191) : ((row - MX) & 255);
                const int key = isx ? 256 + n : n;
#pragma unroll
                for (int bj = 0; bj < 2; ++bj) {
                    const int colb = pn * BM + bj * HALF + wc * 32;
                    f32x4 v0 = acc[ai][bj][m][0], v1 = acc[ai][bj][m][1];
                    if (pn < 2) {
                        *(f32x4*)(FG + (size_t)row * 512 + colb + 4 * fq) = v0; *(f32x4*)(FG + (size_t)row * 512 + colb + 16 + 4 * fq) = v1;
                    } else if (pn < 8) {
                        if (isx) {
                            const int pos = ((colb >> 5) & 1) ? (n & 63) : (n >> 6);
                            const f32x4 c = *(const f32x4*)(ropeC + pos * 16 + 4 * fq), s = *(const f32x4*)(ropeS + pos * 16 + 4 * fq);
                            const f32x4 o0 = v0 * c - v1 * s, o1 = v1 * c + v0 * s; v0 = o0; v1 = o1;
                        }
                        if (pn < 5) {
                            v0 = v0 * qscale; v1 = v1 * qscale;
                            bf16_t* d = Q + (size_t)row * 768 + (colb - 512) + 4 * fq;
                            *(u32x2*)d = (u32x2){pk_bf16(v0[0], v0[1]), pk_bf16(v0[2], v0[3])}; *(u32x2*)(d + 16) = (u32x2){pk_bf16(v1[0], v1[1]), pk_bf16(v1[2], v1[3])};
                        } else {
                            const int ck = colb - 1280 + 4 * fq;
                            const int kk = key & 63, dd = ck & 63;
                            bf16_t* d = Kb + ((size_t)(b * 6 + (ck >> 7)) * 132 + (key >> 6)) * 16384 + (((ck >> 6) & 1) * 64 + kk) * 64 + ((((dd >> 3) ^ ((kk >> 1) & 7)) << 3) | (dd & 7));
                            *(u32x2*)d = (u32x2){pk_bf16(v0[0], v0[1]), pk_bf16(v0[2], v0[3])};
                            bf16_t* d2 = Kb + ((size_t)(b * 6 + (ck >> 7)) * 132 + (key >> 6)) * 16384 + (((ck >> 6) & 1) * 64 + kk) * 64 + (((((dd + 16) >> 3) ^ ((kk >> 1) & 7)) << 3) | (dd & 7));
                            *(u32x2*)d2 = (u32x2){pk_bf16(v1[0], v1[1]), pk_bf16(v1[2], v1[3])};
                        }
                    } else {
                        const int e0 = colb - 2048 + 4 * fq, hh = e0 >> 7, e = e0 & 127;
                        const int kk = key & 63, pos = (kk & 48) + 8 * ((kk >> 2) & 1) + 4 * ((kk >> 3) & 1) + (kk & 3);
                        bf16_t* d = Kb + ((size_t)(b * 6 + hh) * 132 + (key >> 6)) * 16384 + 8192;
#pragma unroll
                        for (int j = 0; j < 4; ++j) {
                            const int ea = e + j, eb2 = e + 16 + j;
                            d[ea * 64 + ((((pos >> 3) ^ ((ea >> 1) & 7)) << 3) | (pos & 7))] = bf16_1(v0[j]);
                            d[eb2 * 64 + ((((pos >> 3) ^ ((eb2 >> 1) & 7)) << 3) | (pos & 7))] = bf16_1(v1[j]);
                        }
                    }
                }
            }
    }
};

struct EpiResGate {
    static constexpr bool PERM = true, AFTER_DRAIN = false;
    const float* res_x; const float* res_c; float* out_x; float* out_c; const float* gate; const float* bias; float alpha; float* part; int kslice;
    const float* stats; const float* lng; const float* lnb;
    __device__ __forceinline__ void operator()(const f32x4 (&acc)[2][2][4][2], const Unit& u, int wr, int wc, int fr, int fq) const {
#pragma unroll
        for (int ai = 0; ai < 2; ++ai)
#pragma unroll
            for (int m = 0; m < 4; ++m) {
                const int row = u.pm * BM + ai * HALF + wr * 64 + m * 16 + fr;
                const bool isx = row < MX;
                const int v = isx ? (row >> 13) : 2;
                const float* rp = isx ? res_x + (size_t)row * 1024 : res_c + (size_t)(row - MX) * 1024;
                float* op = isx ? out_x + (size_t)row * 1024 : out_c + (size_t)(row - MX) * 1024;
                const float* gp = gate + v * 6144;
                float mu = 0.f, rs = 1.f; const bool dl = stats && isx;
                if (dl) { mu = stats[2 * row]; rs = stats[2 * row + 1]; }
#pragma unroll
                for (int bj = 0; bj < 2; ++bj) {
                    const int c0 = u.pn * BM + bj * HALF + wc * 32 + 8 * fq;
#pragma unroll
                    for (int n = 0; n < 2; ++n) {
                        const int c = c0 + 4 * n;
                        const f32x4 g = *(const f32x4*)(gp + c);
                        if (u.atomic) {
                            *(f32x4*)(part + ((size_t)(u.k0 / kslice) * 512 + (row - MX)) * 1024 + c) = g * acc[ai][bj][m][n];
                        } else {
                            f32x4 r = *(const f32x4*)(rp + c); const f32x4 bb = *(const f32x4*)(bias + c);
                            if (dl) r = (r - mu) * rs * *(const f32x4*)(lng + c) + *(const f32x4*)(lnb + c);
                            *(f32x4*)(op + c) = r * alpha + g * (acc[ai][bj][m][n] + bb);
                        }
                    }
                }
            }
    }
};

struct EpiSqRelu {
    static constexpr bool PERM = true, AFTER_DRAIN = false;
    bf16_t* O; int ldc; const float* bias;
    __device__ __forceinline__ void operator()(const f32x4 (&acc)[2][2][4][2], const Unit& u, int wr, int wc, int fr, int fq) const {
#pragma unroll
        for (int ai = 0; ai < 2; ++ai)
#pragma unroll
            for (int m = 0; m < 4; ++m) {
                const int row = u.pm * BM + ai * HALF + wr * 64 + m * 16 + fr;
#pragma unroll
                for (int bj = 0; bj < 2; ++bj) {
                    const int c0 = u.pn * BM + bj * HALF + wc * 32 + 8 * fq;
                    f32x4 v0 = acc[ai][bj][m][0] + *(const f32x4*)(bias + c0), v1 = acc[ai][bj][m][1] + *(const f32x4*)(bias + c0 + 4);
#pragma unroll
                    for (int j = 0; j < 4; ++j) { const float a = fmaxf(v0[j], 0.f), c = fmaxf(v1[j], 0.f); v0[j] = a * a; v1[j] = c * c; }
                    u32x4 w; w.x = pk_bf16(v0[0], v0[1]); w.y = pk_bf16(v0[2], v0[3]); w.z = pk_bf16(v1[0], v1[1]); w.w = pk_bf16(v1[2], v1[3]);
                    *(u32x4*)(O + (size_t)row * ldc + c0) = w;
                }
            }
    }
};

struct EpiInL1 {
    static constexpr bool PERM = true, AFTER_DRAIN = false;
    float* S; float* U; float* V;
    __device__ __forceinline__ void operator()(const f32x4 (&acc)[2][2][4][2], const Unit& u, int wr, int wc, int fr, int fq) const {
        const int t = u.pn >> 1;
        float* base = S + (size_t)t * (33u << 18);
#pragma unroll
        for (int ai = 0; ai < 2; ++ai)
#pragma unroll
            for (int m = 0; m < 4; ++m) {
                const int row = u.pm * BM + ai * HALF + wr * 64 + m * 16 + fr;
                if (t != 0 && row >= MX) continue;
#pragma unroll
                for (int bj = 0; bj < 2; ++bj) {
                    const int c0 = (u.pn & 1) * BM + bj * HALF + wc * 32 + 8 * fq;
                    *(f32x4*)(base + (size_t)row * 512 + c0) = acc[ai][bj][m][0]; *(f32x4*)(base + (size_t)row * 512 + c0 + 4) = acc[ai][bj][m][1];
                }
            }
    }
};

struct EpiGlu {
    static constexpr bool PERM = true, AFTER_DRAIN = false;
    const bf16_t* GAp; bf16_t* Y; const float* bias;
    __device__ __forceinline__ void operator()(const f32x4 (&acc)[2][2][4][2], const Unit& u, int wr, int wc, int fr, int fq) const {
#pragma unroll
        for (int ai = 0; ai < 2; ++ai)
#pragma unroll
            for (int m = 0; m < 4; ++m) {
                const int row = u.pm * BM + ai * HALF + wr * 64 + m * 16 + fr;
#pragma unroll
                for (int bj = 0; bj < 2; ++bj) {
                    const int c0 = u.pn * BM + bj * HALF + wc * 32 + 8 * fq;
                    f32x4 v0 = acc[ai][bj][m][0] + *(const f32x4*)(bias + c0), v1 = acc[ai][bj][m][1] + *(const f32x4*)(bias + c0 + 4);
                    const u32x4 gw = *(const u32x4*)(GAp + (size_t)row * 512 + c0);
                    const f32x4 g0 = {__builtin_bit_cast(float, gw.x << 16), __builtin_bit_cast(float, gw.x & 0xffff0000u), __builtin_bit_cast(float, gw.y << 16), __builtin_bit_cast(float, gw.y & 0xffff0000u)};
                    const f32x4 g1 = {__builtin_bit_cast(float, gw.z << 16), __builtin_bit_cast(float, gw.z & 0xffff0000u), __builtin_bit_cast(float, gw.w << 16), __builtin_bit_cast(float, gw.w & 0xffff0000u)};
#pragma unroll
                    for (int j = 0; j < 4; ++j) { v0[j] = g0[j] * __builtin_amdgcn_rcpf(1.f + __expf(-v0[j])); v1[j] = g1[j] * __builtin_amdgcn_rcpf(1.f + __expf(-v1[j])); }
                    u32x4 w; w.x = pk_bf16(v0[0], v0[1]); w.y = pk_bf16(v0[2], v0[3]); w.z = pk_bf16(v1[0], v1[1]); w.w = pk_bf16(v1[2], v1[3]);
                    *(u32x4*)(Y + (size_t)row * 1024 + c0) = w;
                }
            }
    }
};
template <class Epi, class Sched, bool ALIGN_EPI = false, bool SP2 = false>
__device__ __forceinline__ void gemm_phase(PG8_LAS unsigned char* lds, const Gemm g, const Sched& S, const Epi& E) {
    int tid_o = threadIdx.x; asm volatile("" : "+v"(tid_o));
    const int tid = tid_o, wid = __builtin_amdgcn_readfirstlane(tid >> 6), lane = tid & 63, wr = wid >> 2, wc = wid & 3, fr = lane & 15, fq = lane >> 4;
    const int K = g.K, nt = K / BK;
    unsigned voffA[2], voffB[2];
#pragma unroll
    for (int i = 0; i < 2; ++i) { int R, C; stage_rc(tid * 16 + i * 8192, R, C); const int Rb = Epi::PERM ? ((R & ~31) + perm32(R & 31)) : R;
        voffA[i] = (unsigned)(R * K + C) * 2u; voffB[i] = (unsigned)(Rb * K + C) * 2u; }
    const size_t kstep = (size_t)(BK * 2);
    const size_t hstep = (size_t)HALF * K * 2;
    const size_t tstep = 2 * hstep;
    const unsigned ldsw = (unsigned)wid * 1024u;
    const int aoff = lds_byte(wr * 64 + fr, fq * 8), boff = lds_byte(wc * 32 + fr, fq * 8);
#define PG8_SA(b, h) (((b) * 2 + (h)) * HTB)
#define PG8_SB(b, h) ((4 + (b) * 2 + (h)) * HTB)
#define PG8_STAGE(bufoff, gbase, voff) do { _Pragma("unroll") for (int _i = 0; _i < 2; ++_i) \
        __builtin_amdgcn_global_load_lds((const unsigned*)((const char*)(gbase) + (voff)[_i]), (PG8_LAS unsigned*)(lds + (bufoff) + ldsw + _i * 8192), 16, 0, 0); } while (0)
#define PG8_LDA(dst, b, h) do { _Pragma("unroll") for (int m = 0; m < 4; ++m) _Pragma("unroll") for (int k = 0; k < 2; ++k) dst[m][k] = *(const PG8_LAS bf16x8*)(lds + PG8_SA(b, h) + aoff + m * 2048 + k * 1024); } while (0)
#define PG8_LDB(dst, b, h) do { _Pragma("unroll") for (int n = 0; n < 2; ++n) _Pragma("unroll") for (int k = 0; k < 2; ++k) dst[n][k] = *(const PG8_LAS bf16x8*)(lds + PG8_SB(b, h) + boff + n * 2048 + k * 1024); } while (0)
#define PG8_MMA(ai, bj, At, Bt) do { __builtin_amdgcn_s_setprio(1); _Pragma("unroll") for (int m = 0; m < 4; ++m) _Pragma("unroll") for (int n = 0; n < 2; ++n) _Pragma("unroll") for (int k = 0; k < 2; ++k) \
        acc[ai][bj][m][n] = __builtin_amdgcn_mfma_f32_16x16x32_bf16(Bt[n][k], At[m][k], acc[ai][bj][m][n], 0, 0, 0); __builtin_amdgcn_s_setprio(0); } while (0)
#define PG8_WAIT_V(n) asm volatile("s_waitcnt vmcnt(" #n ")" ::: "memory")
#define PG8_WAIT_L(n) asm volatile("s_waitcnt lgkmcnt(" #n ")" ::: "memory")
#define PG8_BAR __builtin_amdgcn_s_barrier()
#define PG8_SCHED __builtin_amdgcn_sched_barrier(0)
    Unit cur, nxt; int ui = 0;
    if (!S.next(0, cur)) return;
    f32x4 acc[2][2][4][2];
#pragma unroll
    for (int a = 0; a < 2; ++a)
#pragma unroll
        for (int b = 0; b < 2; ++b)
#pragma unroll
            for (int m = 0; m < 4; ++m)
#pragma unroll
                for (int n = 0; n < 2; ++n) acc[a][b][m][n] = (f32x4){0.f, 0.f, 0.f, 0.f};
    bf16x8 At[4][2], B0[2][2], B1[2][2];
    const char* cA = (const char*)g.A + (size_t)cur.pm * tstep + (size_t)cur.k0 * 2; const char* cB = (const char*)g.Bt + (size_t)cur.pn * tstep + (size_t)cur.k0 * 2;
    S.a_ready(cur);
    if constexpr (SP2) {
        PG8_STAGE(PG8_SB(0, 0), cB, voffB); PG8_STAGE(PG8_SB(0, 1), cB + hstep, voffB); PG8_STAGE(PG8_SA(0, 0), cA, voffA); PG8_STAGE(PG8_SA(0, 1), cA + hstep, voffA);
        if (wr == 1) PG8_BAR;
        PG8_WAIT_V(2); PG8_BAR;
        PG8_STAGE(PG8_SB(1, 0), cB + kstep, voffB); PG8_STAGE(PG8_SA(1, 0), cA + kstep, voffA); PG8_STAGE(PG8_SB(1, 1), cB + hstep + kstep, voffB);
        PG8_WAIT_V(6); PG8_BAR;
    } else {
        PG8_STAGE(PG8_SB(0, 0), cB, voffB); PG8_STAGE(PG8_SA(0, 0), cA, voffA); PG8_STAGE(PG8_SB(0, 1), cB + hstep, voffB); PG8_STAGE(PG8_SA(0, 1), cA + hstep, voffA);
        if (wr == 1) PG8_BAR;
        PG8_WAIT_V(4); PG8_BAR;
        PG8_STAGE(PG8_SB(1, 0), cB + kstep, voffB); PG8_STAGE(PG8_SA(1, 0), cA + kstep, voffA); PG8_STAGE(PG8_SB(1, 1), cB + hstep + kstep, voffB);
        PG8_WAIT_V(6); PG8_BAR;
    }
    for (;;) {
        const bool has_next = S.next(ui + 1, nxt);
        const char* nA = has_next ? (const char*)g.A + (size_t)nxt.pm * tstep + (size_t)nxt.k0 * 2 : cA; const char* nB = has_next ? (const char*)g.Bt + (size_t)nxt.pn * tstep + (size_t)nxt.k0 * 2 : cB;
        const int ntc = cur.nt ? cur.nt : nt;
        for (int t = 0; t < ntc; t += 2) {
            const bool last = (t == ntc - 2);
            const char* a1 = cA + (size_t)(t + 1) * kstep;
            const char* a2 = last ? nA : cA + (size_t)(t + 2) * kstep; const char* b2 = last ? nB : cB + (size_t)(t + 2) * kstep;
            const char* a3 = a2 + kstep; const char* b3 = b2 + kstep;
            if (last && has_next) S.a_ready(nxt);
            if constexpr (SP2) {
            PG8_LDB(B0, 0, 0); PG8_LDB(B1, 0, 1); PG8_SCHED; PG8_LDA(At, 0, 0); PG8_STAGE(PG8_SA(1, 1), a1 + hstep, voffA);
            PG8_WAIT_V(8); PG8_WAIT_L(0); PG8_BAR; PG8_MMA(0, 0, At, B0); PG8_MMA(0, 1, At, B1); PG8_BAR; PG8_SCHED;
            PG8_LDA(At, 0, 1); PG8_STAGE(PG8_SB(0, 0), b2, voffB); PG8_STAGE(PG8_SB(0, 1), b2 + hstep, voffB); PG8_STAGE(PG8_SA(0, 0), a2, voffA);
            PG8_WAIT_V(8); PG8_WAIT_L(0); PG8_BAR; PG8_MMA(1, 0, At, B0); PG8_MMA(1, 1, At, B1); PG8_BAR; PG8_SCHED;
            PG8_LDB(B0, 1, 0); PG8_LDB(B1, 1, 1); PG8_SCHED; PG8_LDA(At, 1, 0); PG8_STAGE(PG8_SA(0, 1), a2 + hstep, voffA);
            PG8_WAIT_V(8); PG8_WAIT_L(0); PG8_BAR; PG8_MMA(0, 0, At, B0); PG8_MMA(0, 1, At, B1); PG8_BAR; PG8_SCHED;
            PG8_LDA(At, 1, 1); PG8_STAGE(PG8_SB(1, 0), b3, voffB); PG8_STAGE(PG8_SB(1, 1), b3 + hstep, voffB); PG8_STAGE(PG8_SA(1, 0), a3, voffA);
            PG8_WAIT_V(8); PG8_WAIT_L(0); PG8_BAR; PG8_MMA(1, 0, At, B0); PG8_MMA(1, 1, At, B1); PG8_BAR; PG8_SCHED;
            } else {
            PG8_LDB(B0, 0, 0); PG8_SCHED; PG8_LDA(At, 0, 0); PG8_STAGE(PG8_SA(1, 1), a1 + hstep, voffA);
            PG8_WAIT_L(8); PG8_BAR; PG8_WAIT_L(0); PG8_MMA(0, 0, At, B0); PG8_BAR; PG8_SCHED;
            PG8_LDB(B1, 0, 1); PG8_STAGE(PG8_SB(0, 0), b2, voffB);
            PG8_BAR; PG8_WAIT_L(0); PG8_MMA(0, 1, At, B1); PG8_BAR;
            PG8_LDA(At, 0, 1); PG8_STAGE(PG8_SA(0, 0), a2, voffA);
            PG8_BAR; PG8_WAIT_L(0); PG8_MMA(1, 0, At, B0); PG8_BAR; PG8_SCHED;
            PG8_STAGE(PG8_SB(0, 1), b2 + hstep, voffB);
            PG8_WAIT_V(6); PG8_BAR; PG8_MMA(1, 1, At, B1); PG8_BAR;
            PG8_LDB(B0, 1, 0); PG8_SCHED; PG8_LDA(At, 1, 0); PG8_STAGE(PG8_SA(0, 1), a2 + hstep, voffA);
            PG8_WAIT_L(8); PG8_BAR; PG8_WAIT_L(0); PG8_MMA(0, 0, At, B0); PG8_BAR; PG8_SCHED;
            PG8_LDB(B1, 1, 1); PG8_STAGE(PG8_SB(1, 0), b3, voffB);
            PG8_BAR; PG8_WAIT_L(0); PG8_MMA(0, 1, At, B1); PG8_BAR;
            PG8_LDA(At, 1, 1); PG8_STAGE(PG8_SA(1, 0), a3, voffA);
            PG8_BAR; PG8_WAIT_L(0); PG8_MMA(1, 0, At, B0); PG8_BAR; PG8_SCHED;
            PG8_STAGE(PG8_SB(1, 1), b3 + hstep, voffB);
            PG8_WAIT_V(6); PG8_BAR; PG8_MMA(1, 1, At, B1); PG8_BAR;
            }
        }
        if constexpr (ALIGN_EPI) { if (wr == 0) PG8_BAR; }
        if constexpr (!Epi::AFTER_DRAIN) { E(acc, cur, wr, wc, fr, fq); S.done(cur); }
        if (!has_next) break;
#pragma unroll
        for (int a = 0; a < 2; ++a)
#pragma unroll
            for (int b = 0; b < 2; ++b)
#pragma unroll
                for (int m = 0; m < 4; ++m)
#pragma unroll
                    for (int n = 0; n < 2; ++n) acc[a][b][m][n] = (f32x4){0.f, 0.f, 0.f, 0.f};
        cur = nxt; cA = nA; cB = nB; ++ui;
        if constexpr (ALIGN_EPI) { if (wr == 1) PG8_BAR; }
    }
    PG8_WAIT_V(0);
    if constexpr (!ALIGN_EPI) { if (wr == 0) PG8_BAR; }
    PG8_BAR;
    if constexpr (Epi::AFTER_DRAIN) { E.fused(acc, cur, wr, wc, fr, fq, lds, wid, lane); S.done(cur); }
#undef PG8_SA
#undef PG8_SB
#undef PG8_STAGE
#undef PG8_LDA
#undef PG8_LDB
#undef PG8_MMA
#undef PG8_WAIT_V
#undef PG8_WAIT_L
#undef PG8_BAR
#undef PG8_SCHED
}
}

#define DI __device__ __forceinline__
#define LAS __attribute__((address_space(3)))
typedef unsigned short bf16;
typedef float f32x4 __attribute__((ext_vector_type(4)));
typedef float f32x16 __attribute__((ext_vector_type(16)));
typedef short bf16x8 __attribute__((ext_vector_type(8)));
typedef short s16x4 __attribute__((ext_vector_type(4)));
typedef unsigned u32x4 __attribute__((ext_vector_type(4)));
typedef unsigned u32x2 __attribute__((ext_vector_type(2)));
using pg8::pk_bf16; using pg8::bf16_1;

constexpr int NWAVES = 8, NTHR = 512;
constexpr int LDS_BYTES = 147456;
constexpr int D = 1024, MX = 16384, MC = 512, MALL = MX + MC, SEQ = 8192, CTX = 256, NKEY = 8448, FF = 4096;
constexpr float LN_EPS = 1e-5f;
constexpr float ALPHA = 1.41421356237309515f;
constexpr size_t MiB = 1u << 20;
constexpr size_t WS_MODP = 0;
constexpr size_t WS_MOD = 2 * MiB + 256 * 1024;
constexpr size_t WS_ROPE = 2 * MiB + 512 * 1024;
constexpr size_t WS_ST1 = 7 * MiB + 256 * 1024, WS_ST2 = WS_ST1 + 128 * 1024;
constexpr size_t WS_BAR = 2 * MiB + 768 * 1024;
constexpr size_t WS_E = 3 * MiB;
constexpr size_t WS_XC = 8 * MiB;
constexpr size_t WS_WIN0 = 10 * MiB;
constexpr size_t WS_WOUT = 16 * MiB;
constexpr size_t WS_W1 = 20 * MiB;
constexpr size_t WS_W2 = 36 * MiB;
constexpr size_t WS_WCD = 52 * MiB;
constexpr size_t WS_WGLU = 55 * MiB;
constexpr size_t WS_H = 56 * MiB;
constexpr size_t WS_Y = 89 * MiB;
constexpr size_t WS_BIG = 122 * MiB;
constexpr size_t WS_Q = WS_BIG, WS_K = WS_BIG + 25 * MiB, WS_VT = WS_BIG + 50 * MiB, WS_FG = WS_BIG + 75 * MiB;
constexpr size_t WS_S = WS_BIG, WS_U = WS_BIG + 33 * MiB, WS_V = WS_BIG + 66 * MiB, WS_GA = WS_BIG + 99 * MiB;
constexpr size_t WS_END = 254 * MiB;

struct Args { const float* in[35]; float* out; unsigned char* ws; int ph_lo, ph_hi; };

DI float wave_sum(float v) {
#pragma unroll
    for (int o = 1; o < 64; o <<= 1) v += __shfl_xor(v, o);
    return v;
}
#define LDS_WAIT() asm volatile("s_waitcnt lgkmcnt(0)" ::: "memory")

DI void transpose_item(const float* W, int K, int N, bf16* WT, int row_off, float* scr, int kb, int nb, int lane) {
    const int k0 = 64 * kb, n0 = 32 * nb;
    float tv[32];
#pragma unroll
    for (int i = 0; i < 32; ++i) { const int kk = 2 * i + (lane >> 5); tv[i] = W[(size_t)(k0 + kk) * N + n0 + (lane & 31)]; }
#pragma unroll
    for (int i = 0; i < 32; ++i) { const int kk = 2 * i + (lane >> 5); scr[kk * 33 + (lane & 31)] = tv[i]; }
    LDS_WAIT(); asm volatile("" ::: "memory");
    const int c = lane & 7;
#pragma unroll
    for (int j = 0; j < 4; ++j) { const int n = (lane >> 3) + 8 * j; const float* s = scr + (8 * c) * 33 + n;
        u32x4 o; o.x = pk_bf16(s[0 * 33], s[1 * 33]); o.y = pk_bf16(s[2 * 33], s[3 * 33]); o.z = pk_bf16(s[4 * 33], s[5 * 33]); o.w = pk_bf16(s[6 * 33], s[7 * 33]);
        *(u32x4*)(WT + (size_t)(row_off + n0 + n) * K + k0 + 8 * c) = o; }
    LDS_WAIT(); asm volatile("" ::: "memory");
}

#define XB_TMO      128
#define XB_XCNT(j)  (256  + 64 * (j))
#define XB_XSUB(j)  (1280 + 64 * (j))
#define XB_XGEN(j)  (2304 + 64 * (j))
#define XB_TOP      3328
#define XB_TOPGEN   3392
#define XCD_BAR_WORDS 3456
#define XB_SPIN_CAP (1u << 18)

__device__ __forceinline__ unsigned xb_ld(unsigned* p)              { return __hip_atomic_load(p, __ATOMIC_RELAXED, __HIP_MEMORY_SCOPE_AGENT); }
__device__ __forceinline__ unsigned xb_add(unsigned* p, unsigned v) { return __hip_atomic_fetch_add(p, v, __ATOMIC_RELAXED, __HIP_MEMORY_SCOPE_AGENT); }
__device__ __forceinline__ unsigned xb_xcc_id() { return (unsigned)__builtin_amdgcn_s_getreg((3 << 11) | 20) & 0xFu; }
#define XB_SPIN(cond, bar) do { unsigned _sp = 0; while (cond) { __builtin_amdgcn_s_sleep(1); \
    if ((++_sp & 255u) == 0u) { if (xb_ld(&(bar)[XB_TMO])) break; if (_sp > XB_SPIN_CAP) { atomicAdd(&(bar)[XB_TMO], 1u); break; } } } } while (0)

struct XcdBarrier {
    unsigned* bar; unsigned x;
    volatile LAS unsigned* st;
};

__device__ __forceinline__ XcdBarrier xcd_barrier_post(unsigned* bar, volatile LAS unsigned* st) {
    XcdBarrier b; b.bar = bar; b.x = xb_xcc_id(); b.st = st;
    if (threadIdx.x == 0) (void)xb_add(&bar[XB_XCNT(b.x)], 1u);
    return b;
}
__device__ __forceinline__ void xcd_barrier_complete(unsigned* bar, unsigned x, unsigned& nloc, unsigned& nx) {
    const unsigned G = gridDim.x * gridDim.y * gridDim.z;
    unsigned sum, cnt, mine, sp = 0u;
    for (;;) {
        sum = 0u; cnt = 0u; mine = 0u;
#pragma unroll
        for (unsigned j = 0; j < 16; ++j) { const unsigned c = xb_ld(&bar[XB_XCNT(j)]); sum += c; cnt += (c > 0u) ? 1u : 0u; mine = (j == x) ? c : mine; }
        if (sum == G) break;
        __builtin_amdgcn_s_sleep(1);
        if ((++sp & 255u) == 0u) { if (xb_ld(&bar[XB_TMO])) break; if (sp > XB_SPIN_CAP) { atomicAdd(&bar[XB_TMO], 1u); break; } }
    }
    nloc = mine > 0u ? mine : 1u; nx = cnt > 0u ? cnt : 1u;
}

__device__ __forceinline__ void xcd_barrier(const XcdBarrier& b) {
    asm volatile("s_waitcnt vmcnt(0)" ::: "memory");
    __syncthreads();
    if (threadIdx.x == 0) {
        unsigned* bar = b.bar;
        __builtin_amdgcn_s_waitcnt(0);
        unsigned nloc = b.st[0], nx = b.st[1];
        if (nloc == 0u) { xcd_barrier_complete(bar, b.x, nloc, nx); b.st[0] = nloc; b.st[1] = nx; }
        const unsigned old = xb_add(&bar[XB_XSUB(b.x)], 1u);
        const unsigned gen = old / nloc;
        if (old + 1u == (gen + 1u) * nloc) {
            __builtin_amdgcn_fence(__ATOMIC_RELEASE, "agent");
            asm volatile("s_waitcnt vmcnt(0)" ::: "memory");
            const unsigned og = xb_add(&bar[XB_TOP], 1u);
            const unsigned tg = og / nx;
            if (og + 1u == (tg + 1u) * nx) xb_add(&bar[XB_TOPGEN], 1u);
            else XB_SPIN(xb_ld(&bar[XB_TOPGEN]) == tg, bar);
            __builtin_amdgcn_fence(__ATOMIC_ACQUIRE, "agent");
            xb_add(&bar[XB_XGEN(b.x)], 1u);
            asm volatile("s_waitcnt vmcnt(0)" ::: "memory");
        } else {
            XB_SPIN(xb_ld(&bar[XB_XGEN(b.x)]) == gen, bar);
            __builtin_amdgcn_fence(__ATOMIC_ACQUIRE, "agent");
            asm volatile("s_waitcnt vmcnt(0)" ::: "memory");
        }
    }
    __syncthreads();
}

DI void ln_phase(const float* src_x, const float* src_c, float* dst_x, float* dst_c, int nrows, const float* g, const float* bta,
                 const float* mod_sh, const float* mod_sc, bf16* H, int gw, int ngw, int lane, const float* cg = nullptr, const float* cb = nullptr, const float* part = nullptr, int nparts = 0, float* stats = nullptr) {
    for (int row = gw; row < nrows; row += ngw) {
        const bool isx = row < MX; const int v = isx ? (row >> 13) : 2;
        const float* sp = isx ? src_x + (size_t)row * D : src_c + (size_t)(row - MX) * D;
        f32x4 x[4]; float s = 0.f;
#pragma unroll
        for (int j = 0; j < 4; ++j) { x[j] = *(const f32x4*)(sp + (lane + 64 * j) * 4);
            if (part && !isx) for (int k = 0; k < nparts; ++k) x[j] = x[j] + *(const f32x4*)(part + ((size_t)k * 512 + (row - MX)) * D + (lane + 64 * j) * 4);
            s += (x[j][0] + x[j][1]) + (x[j][2] + x[j][3]); }
        float mean = wave_sum(s) * (1.f / D), s2 = 0.f;
#pragma unroll
        for (int j = 0; j < 4; ++j) { x[j] = x[j] - mean; s2 += (x[j][0] * x[j][0] + x[j][1] * x[j][1]) + (x[j][2] * x[j][2] + x[j][3] * x[j][3]); }
        float rstd = rsqrtf(wave_sum(s2) * (1.f / D) + LN_EPS);
        if (!g && cg && !isx) {
            float* dp = dst_c + (size_t)(row - MX) * D;
#pragma unroll
            for (int j = 0; j < 4; ++j) { const int c = (lane + 64 * j) * 4; *(f32x4*)(dp + c) = (x[j] + mean) * ALPHA + *(const f32x4*)(cg + c) * *(const f32x4*)(cb + c); }
        }
        if (g) {
            if (stats && isx && lane == 0) { stats[2 * row] = mean; stats[2 * row + 1] = rstd; }
            float* dp = isx ? dst_x + (size_t)row * D : dst_c + (size_t)(row - MX) * D;
            s = 0.f;
#pragma unroll
            for (int j = 0; j < 4; ++j) { const int c = (lane + 64 * j) * 4; x[j] = x[j] * rstd * *(const f32x4*)(g + c) + *(const f32x4*)(bta + c);
                if (!(stats && isx)) *(f32x4*)(dp + c) = (cg && !isx) ? x[j] * ALPHA + *(const f32x4*)(cg + c) * *(const f32x4*)(cb + c) : x[j];
                s += (x[j][0] + x[j][1]) + (x[j][2] + x[j][3]); }
            if (H) {
                mean = wave_sum(s) * (1.f / D); s2 = 0.f;
#pragma unroll
                for (int j = 0; j < 4; ++j) { x[j] = x[j] - mean; s2 += (x[j][0] * x[j][0] + x[j][1] * x[j][1]) + (x[j][2] * x[j][2] + x[j][3] * x[j][3]); }
                rstd = rsqrtf(wave_sum(s2) * (1.f / D) + LN_EPS);
            }
        }
        if (H) {
            bf16* hp = H + (size_t)row * D;
#pragma unroll
            for (int j = 0; j < 4; ++j) { const int c = (lane + 64 * j) * 4;
                const f32x4 sc = *(const f32x4*)(mod_sc + v * 6144 + c), sh = *(const f32x4*)(mod_sh + v * 6144 + c);
                const f32x4 h = x[j] * rstd * (sc + 1.f) + sh;
                *(u32x2*)(hp + c) = (u32x2){pk_bf16(h[0], h[1]), pk_bf16(h[2], h[3])}; }
        }
    }
}

namespace att {
constexpr int OP = 132;
#define MFMA32(a, b, c) __builtin_amdgcn_mfma_f32_32x32x16_bf16((a), (b), (c), 0, 0, 0)
DI int crow(int i, int h) { return (i & 3) + 8 * (i >> 2) + 4 * h; }

template <int VAR = 0>
DI void attn_unit(unsigned char* lds, const bf16* Q, const bf16* Kb, const bf16* Vt, bf16* Y, int b, int hh, int qrow0, int nkeys, float lam, const float* subg,
                  int tid, int wave, int lane, int yrow0 = -1) {
    if (yrow0 < 0) yrow0 = qrow0;
    const int map = wave >> 2, qsub = wave & 3, r = lane & 31, h = lane >> 5;
    const unsigned char* kvbase = (const unsigned char*)(Kb + (size_t)(b * 6 + hh) * 132 * 16384);
    (void)Vt;
    constexpr int TILE_B = 32768;
    auto issue = [&](int t) __attribute__((always_inline)) {
        const unsigned char* src = kvbase + (size_t)t * TILE_B + wave * 1024 + lane * 16;
        LAS unsigned char* dst = (LAS unsigned char*)lds + (t & 3) * TILE_B + wave * 1024;
#pragma unroll
        for (int i = 0; i < 4; ++i) __builtin_amdgcn_global_load_lds((const unsigned*)(src + i * 8192), (LAS unsigned*)(dst + i * 8192), 16, 0, 0);
    };
    int offs[4];
#pragma unroll
    for (int s = 0; s < 4; ++s) offs[s] = r * 128 + ((((2 * s + h) ^ ((r >> 1) & 7))) << 4);
    bf16x8 qf[4];
    { const bf16* qp = Q + (size_t)(qrow0 + qsub * 32 + r) * 768 + hh * 128 + map * 64 + 8 * h;
#pragma unroll
      for (int s = 0; s < 4; ++s) qf[s] = *(const bf16x8*)(qp + 16 * s); }
    f32x16 O[4];
#pragma unroll
    for (int e = 0; e < 4; ++e)
#pragma unroll
        for (int i = 0; i < 16; ++i) O[e][i] = 0.f;
    float mrun = -INFINITY, lrun = 0.f;
    const int nt = nkeys >> 6;
#define ATT_BAR() do { __builtin_amdgcn_sched_barrier(0); asm volatile("s_waitcnt lgkmcnt(0)\n\ts_barrier" ::: "memory"); __builtin_amdgcn_sched_barrier(0); } while (0)
#define ATT_VMWAIT(younger_exists) do { if (younger_exists) asm volatile("s_waitcnt vmcnt(4)" ::: "memory"); else asm volatile("s_waitcnt vmcnt(0)" ::: "memory"); } while (0)
#define ATT_QK(slot_t) do { const unsigned char* kt_ = lds + ((slot_t) & 3) * TILE_B + map * 8192; bf16x8 kf0[4], kf1[4]; \
        _Pragma("unroll") for (int s = 0; s < 4; ++s) { kf0[s] = *(const bf16x8*)(kt_ + offs[s]); kf1[s] = *(const bf16x8*)(kt_ + 4096 + offs[s]); } \
        __builtin_amdgcn_sched_barrier(0); \
        _Pragma("unroll") for (int i = 0; i < 16; ++i) { x0[i] = 0.f; x1[i] = 0.f; } \
        _Pragma("unroll") for (int s = 0; s < 4; ++s) { x0 = MFMA32(kf0[s], qf[s], x0); x1 = MFMA32(kf1[s], qf[s], x1); } } while (0)
#define ATT_PINX() do { \
        asm volatile("" : "+v"(x0[0]), "+v"(x0[1]), "+v"(x0[2]), "+v"(x0[3]), "+v"(x0[4]), "+v"(x0[5]), "+v"(x0[6]), "+v"(x0[7]), "+v"(x0[8]), "+v"(x0[9]), "+v"(x0[10]), "+v"(x0[11]), "+v"(x0[12]), "+v"(x0[13]), "+v"(x0[14]), "+v"(x0[15])); \
        asm volatile("" : "+v"(x1[0]), "+v"(x1[1]), "+v"(x1[2]), "+v"(x1[3]), "+v"(x1[4]), "+v"(x1[5]), "+v"(x1[6]), "+v"(x1[7]), "+v"(x1[8]), "+v"(x1[9]), "+v"(x1[10]), "+v"(x1[11]), "+v"(x1[12]), "+v"(x1[13]), "+v"(x1[14]), "+v"(x1[15])); } while (0)
    f32x16 x0, x1;
    asm volatile("s_waitcnt vmcnt(0)" ::: "memory");
    issue(0); issue(1); issue(2);
    asm volatile("s_waitcnt vmcnt(4)" ::: "memory");
    __syncthreads();
    ATT_QK(0);
    ATT_PINX();
    if (map == 1) ATT_BAR();
#pragma unroll 1
    for (int t = 0; t < nt; ++t) {
        if (VAR != 3 && map == 1 && t + 3 < nt) issue(t + 3);
        float tm = x0[0];
#pragma unroll
        for (int i = 1; i < 16; ++i) tm = fmaxf(tm, x0[i]);
#pragma unroll
        for (int i = 0; i < 16; ++i) tm = fmaxf(tm, x1[i]);
        tm = fmaxf(tm, __shfl_xor(tm, 32));
        const float mnew = fmaxf(mrun, tm);
        if (__ballot(mnew > mrun + 8.f) != 0ull) {
            const float al = __builtin_amdgcn_exp2f(mrun - mnew);
            lrun *= al;
#pragma unroll
            for (int e = 0; e < 4; ++e)
#pragma unroll
                for (int i = 0; i < 16; ++i) O[e][i] *= al;
            mrun = mnew;
        }
        float ps0 = 0.f, ps1 = 0.f;
#pragma unroll
        for (int i = 0; i < 16; ++i) { if (VAR == 1) { x0[i] = x0[i] - mrun; x1[i] = x1[i] - mrun; } else { x0[i] = __builtin_amdgcn_exp2f(x0[i] - mrun); x1[i] = __builtin_amdgcn_exp2f(x1[i] - mrun); } ps0 += x0[i]; ps1 += x1[i]; }
        lrun += ps0 + ps1;
        u32x4 pw[4];
#pragma unroll
        for (int st = 0; st < 2; ++st) {
            const int o = 8 * st;
            pw[st].x = pk_bf16(x0[o], x0[o + 1]); pw[st].y = pk_bf16(x0[o + 2], x0[o + 3]); pw[st].z = pk_bf16(x0[o + 4], x0[o + 5]); pw[st].w = pk_bf16(x0[o + 6], x0[o + 7]);
            pw[2 + st].x = pk_bf16(x1[o], x1[o + 1]); pw[2 + st].y = pk_bf16(x1[o + 2], x1[o + 3]); pw[2 + st].z = pk_bf16(x1[o + 4], x1[o + 5]); pw[2 + st].w = pk_bf16(x1[o + 6], x1[o + 7]);
        }
        asm volatile("" : "+v"(pw[0].x), "+v"(pw[0].y), "+v"(pw[0].z), "+v"(pw[0].w), "+v"(pw[1].x), "+v"(pw[1].y), "+v"(pw[1].z), "+v"(pw[1].w),
                          "+v"(pw[2].x), "+v"(pw[2].y), "+v"(pw[2].z), "+v"(pw[2].w), "+v"(pw[3].x), "+v"(pw[3].y), "+v"(pw[3].z), "+v"(pw[3].w), "+v"(lrun));
        if (map == 0) ATT_VMWAIT(t + 2 < nt);
        ATT_BAR();
        if (VAR != 3 && map == 0 && t + 3 < nt) issue(t + 3);
        {
            const unsigned char* vt = lds + (t & 3) * TILE_B + 16384;
#define ATT_VLD(dst, st) do { _Pragma("unroll") for (int eb = 0; eb < 4; ++eb) dst[eb] = *(const bf16x8*)(vt + eb * 4096 + offs[st]); } while (0)
#define ATT_PV(src, st) do { const bf16x8 pf = __builtin_bit_cast(bf16x8, pw[st]); _Pragma("unroll") for (int eb = 0; eb < 4; ++eb) { if (VAR == 2) { O[eb][0] += (float)src[eb][0] * (float)pf[0]; } else O[eb] = MFMA32(src[eb], pf, O[eb]); } } while (0)
            bf16x8 va[4], vb[4];
            ATT_VLD(va, 0); ATT_VLD(vb, 1);
            __builtin_amdgcn_sched_barrier(0);
            ATT_PV(va, 0);
            __builtin_amdgcn_sched_barrier(0);
            ATT_VLD(va, 2);
            __builtin_amdgcn_sched_barrier(0);
            ATT_PV(vb, 1);
            __builtin_amdgcn_sched_barrier(0);
            ATT_VLD(vb, 3);
            __builtin_amdgcn_sched_barrier(0);
            ATT_PV(va, 2);
            ATT_PV(vb, 3);
        }
        __builtin_amdgcn_sched_barrier(0);
        if (t + 1 < nt) { ATT_QK(t + 1); }
        ATT_PINX();
        if (map == 1) ATT_VMWAIT(t + 3 < nt);
        ATT_BAR();
    }
    if (map == 0) ATT_BAR();
    asm volatile("s_waitcnt vmcnt(0)" ::: "memory");
    __syncthreads();
    const float lt = lrun + __shfl_xor(lrun, 32), inv = 1.f / lt;
    float* ob = (float*)lds;
    if (map == 1) {
#pragma unroll
        for (int eb = 0; eb < 4; ++eb)
#pragma unroll
            for (int i4 = 0; i4 < 4; ++i4) {
                f32x4 v = {O[eb][4 * i4] * inv, O[eb][4 * i4 + 1] * inv, O[eb][4 * i4 + 2] * inv, O[eb][4 * i4 + 3] * inv};
                *(f32x4*)(ob + (qsub * 32 + r) * OP + 32 * eb + 8 * i4 + 4 * h) = v;
            }
    }
    __syncthreads();
    if (map == 0) {
        float ss = 0.f;
#pragma unroll
        for (int eb = 0; eb < 4; ++eb)
#pragma unroll
            for (int i4 = 0; i4 < 4; ++i4) {
                const f32x4 o1 = *(const f32x4*)(ob + (qsub * 32 + r) * OP + 32 * eb + 8 * i4 + 4 * h);
#pragma unroll
                for (int j = 0; j < 4; ++j) { const float d = O[eb][4 * i4 + j] * inv - lam * o1[j]; O[eb][4 * i4 + j] = d; ss += d * d; }
            }
        ss += __shfl_xor(ss, 32);
        const float rn = rsqrtf(ss * (1.f / 128.f) + LN_EPS) * 0.8f;
        bf16* yp = Y + (size_t)(yrow0 + qsub * 32 + r) * D + 256 + hh * 128;
#pragma unroll
        for (int eb = 0; eb < 4; ++eb)
#pragma unroll
            for (int i4 = 0; i4 < 4; ++i4) {
                const int e = 32 * eb + 8 * i4 + 4 * h;
                const f32x4 g = *(const f32x4*)(subg + e);
                *(u32x2*)(yp + e) = (u32x2){pk_bf16(O[eb][4 * i4] * rn * g[0], O[eb][4 * i4 + 1] * rn * g[1]), pk_bf16(O[eb][4 * i4 + 2] * rn * g[2], O[eb][4 * i4 + 3] * rn * g[3])};
            }
    }
    __syncthreads();
}
}

DI void fft_lds_cols64(float2* X, const float2* TW, int logN, int tid) {
    const int N = 1 << logN, nb = (N >> 1) * 64;
    for (int s = 1; s <= logN; ++s) {
        const int half = 1 << (s - 1), tsh = 7 - s;
#pragma unroll 4
        for (int t = tid; t < nb; t += NTHR) {
            const int c = t & 63, bf = t >> 6, j = bf & (half - 1), grp = bf >> (s - 1);
            const int i0 = (grp << s) + j, i1 = i0 + half;
            const float2 w = TW[j << tsh];
            const float2 a = X[i0 * 64 + c], bq = X[i1 * 64 + c];
            const float tr = w.x * bq.x - w.y * bq.y, ti = w.x * bq.y + w.y * bq.x;
            X[i0 * 64 + c] = make_float2(a.x + tr, a.y + ti); X[i1 * 64 + c] = make_float2(a.x - tr, a.y - ti);
        }
        __syncthreads();
    }
}
DI int bitrev(int v, int bits) { return (int)(__brev((unsigned)v) >> (32 - bits)); }
constexpr int FFT_TW_OFF = 65536, FFT_TW2_OFF = 65536 + 512;

template <int logN1>
DI void fft_step1(unsigned char* lds, const float* FG, unsigned* T, int bg, int g, int rowbase, int n2, int tid) {
    float2* X = (float2*)lds; float2* TW = (float2*)(lds + FFT_TW_OFF); float2* TW2 = (float2*)(lds + FFT_TW2_OFF); constexpr int N1 = 1 << logN1;
    if (tid < 64) { float sn, cs; sincospif(-(float)tid * (1.f / 64.f), &sn, &cs); TW[tid] = make_float2(cs, sn); }
    else if (tid < 64 + N1) { const int k1 = tid - 64; float sn, cs; sincospif(-2.f * (float)(n2 * k1) / (float)(64 * N1), &sn, &cs); TW2[k1] = make_float2(cs, sn); }
    {
        constexpr int NIT = (N1 * 64 + NTHR - 1) / NTHR;
        float vr[NIT], vi[NIT];
#pragma unroll
        for (int i = 0; i < NIT; ++i) { const int t = tid + i * NTHR; if (t < N1 * 64) { const int c = t & 63, n1 = t >> 6; const float* p = FG + (size_t)(rowbase + 64 * n1 + n2) * 512 + g * 128 + c; vr[i] = p[0]; vi[i] = p[64]; } }
#pragma unroll
        for (int i = 0; i < NIT; ++i) { const int t = tid + i * NTHR; if (t < N1 * 64) { const int c = t & 63, n1 = t >> 6; X[bitrev(n1, logN1) * 64 + c] = make_float2(vr[i], vi[i]); } }
    }
    __syncthreads();
    fft_lds_cols64(X, TW, logN1, tid);
    for (int t = tid; t < N1 * 64; t += NTHR) { const int c = t & 63, k1 = t >> 6; const float2 w = TW2[k1];
        const float2 a = X[k1 * 64 + c];
        T[((size_t)(bg * N1 + k1) * 64 + n2) * 64 + c] = pk_bf16(a.x * w.x - a.y * w.y, a.x * w.y + a.y * w.x); }
    __syncthreads();
}
DI void fft_step3(unsigned char* lds, const unsigned* T, bf16* Y, int bg, int g, int rowbase, int k1, int N1, float scale, int tid) {
    float2* X = (float2*)lds; float2* TW = (float2*)(lds + FFT_TW_OFF);
    if (tid < 64) { float sn, cs; sincospif(-(float)tid * (1.f / 64.f), &sn, &cs); TW[tid] = make_float2(cs, sn); }
    {
        float2 v[8];
#pragma unroll
        for (int i = 0; i < 8; ++i) { const int t = tid + i * NTHR, c = t & 63, n2 = t >> 6; const unsigned w = T[((size_t)(bg * N1 + k1) * 64 + n2) * 64 + c];
            v[i] = make_float2(__builtin_bit_cast(float, w << 16), __builtin_bit_cast(float, w & 0xffff0000u)); }
#pragma unroll
        for (int i = 0; i < 8; ++i) { const int t = tid + i * NTHR, c = t & 63, n2 = t >> 6; X[bitrev(n2, 6) * 64 + c] = v[i]; }
    }
    __syncthreads();
    fft_lds_cols64(X, TW, 6, tid);
    for (int t = tid; t < 64 * 64; t += NTHR) { const int c = t & 63, k2 = t >> 6; Y[(size_t)(rowbase + k1 + N1 * k2) * D + g * 64 + c] = bf16_1(X[k2 * 64 + c].x * scale); }
    __syncthreads();
}

struct S5Lane { float ar, ai; float br[16], bi[16]; };
DI void s5_lane_params(S5Lane& P, const float* lam_re, const float* lam_im, const float* log_dt, const float* b_re, const float* b_im, int r, int g, int p) {
    const int gi = r * 32 + g; const float lr = lam_re[gi * 64 + p], li = lam_im[gi * 64 + p], dt = expf(log_dt[gi]);
    const float mag = expf(lr * dt); float sn, cs; sincosf(li * dt, &sn, &cs);
    P.ar = mag * cs; P.ai = mag * sn;
    const float nr = P.ar - 1.f, ni = P.ai, den = 1.f / (lr * lr + li * li);
    const float fr = (nr * lr + ni * li) * den, fi = (ni * lr - nr * li) * den;
#pragma unroll
    for (int i = 0; i < 16; ++i) { const float xr = b_re[(size_t)(gi * 64 + p) * 16 + i], xi = b_im[(size_t)(gi * 64 + p) * 16 + i]; P.br[i] = fr * xr - fi * xi; P.bi[i] = fr * xi + fi * xr; }
}
DI int s5_chunk_row(int b, int c) { return c < 2 ? MX + b * 256 + c * 128 : b * SEQ + (c - 2) * 128; }
DI void s5_stage_u(float* ul, const float* S, int row0, int g, int lane) {
#pragma unroll
    for (int it = 0; it < 8; ++it) { const int t = it * 16 + (lane >> 2), q = lane & 3; *(f32x4*)(ul + t * 16 + q * 4) = *(const f32x4*)(S + (size_t)(row0 + t) * 512 + g * 16 + q * 4); }
    LDS_WAIT(); asm volatile("" ::: "memory");
}
DI void s5_step(const S5Lane& P, const float* ut, float& hr, float& hi) {
    float br = 0.f, bi = 0.f;
#pragma unroll
    for (int q = 0; q < 4; ++q) { const f32x4 u = *(const f32x4*)(ut + 4 * q);
#pragma unroll
        for (int j = 0; j < 4; ++j) { br += P.br[4 * q + j] * u[j]; bi += P.bi[4 * q + j] * u[j]; } }
    const float nr = P.ar * hr - P.ai * hi + br, ni = P.ar * hi + P.ai * hr + bi; hr = nr; hi = ni;
}
DI void s5_pass_a(float* wl, const float* S, float2* E, const float* const* in, int item, int lane) {
    const int c = item % 66, r = (item / 66) & 1, g = (item / 132) & 31, b = item / (132 * 32);
    S5Lane P; s5_lane_params(P, in[23], in[24], in[25], in[26], in[27], r, g, lane);
    s5_stage_u(wl, S, s5_chunk_row(b, c), g, lane);
    float hr = 0.f, hi = 0.f;
    for (int t = 0; t < 128; ++t) s5_step(P, wl + (r ? 127 - t : t) * 16, hr, hi);
    E[(size_t)(((b * 32 + g) * 2 + r) * 66 + c) * 64 + lane] = make_float2(hr, hi);
    LDS_WAIT(); asm volatile("" ::: "memory");
}
DI float gelu_tanh(float x) { const float z = 0.7978845608028654f * (x + 0.044715f * x * x * x); return x - x / (1.f + __expf(2.f * z)); }
DI void s5_pass_b(float* wl, const float* S, const float2* E, float* GF, bf16* GA, const float* const* in, int item, int lane) {
    typedef float f32x4v __attribute__((ext_vector_type(4)));
    const int c = item & 63, g = (item >> 6) & 31, b = item >> 11;
    float* ul = wl;
    unsigned char* hs = (unsigned char*)(wl + 2048);
    const int row0 = b * SEQ + c * 128, fr = lane & 15, fq = lane >> 4;
    s5_stage_u(ul, S, row0, g, lane);
    const float dsk = in[30][g * 16 + fr];
    f32x4v yf[8];
#pragma unroll 1
    for (int r = 0; r < 2; ++r) {
        S5Lane P; s5_lane_params(P, in[23], in[24], in[25], in[26], in[27], r, g, lane);
        bf16x8 cf[4];
#pragma unroll
        for (int ks = 0; ks < 4; ++ks) {
            const size_t o = (size_t)((r * 32 + g) * 16 + fr) * 64 + 16 * ks + 4 * fq;
            const f32x4v cr = *(const f32x4v*)(in[28] + o), ci = *(const f32x4v*)(in[29] + o);
            u32x4 w; w.x = pk_bf16(cr[0], -ci[0]); w.y = pk_bf16(cr[1], -ci[1]); w.z = pk_bf16(cr[2], -ci[2]); w.w = pk_bf16(cr[3], -ci[3]);
            cf[ks] = __builtin_bit_cast(bf16x8, w);
        }
        float pr = P.ar, pi = P.ai;
#pragma unroll
        for (int k = 0; k < 7; ++k) { const float nr = pr * pr - pi * pi, ni = 2.f * pr * pi; pr = nr; pi = ni; }
        const float2* Eb = E + (size_t)(((b * 32 + g) * 2 + r) * 66) * 64 + lane;
        float hr = 0.f, hi = 0.f;
        {
            const int n = r == 0 ? c + 2 : 65 - c;
#pragma unroll 1
            for (int k0 = 0; k0 < n; k0 += 8) {
                float2 e[8];
#pragma unroll
                for (int j = 0; j < 8; ++j) { const int k = k0 + j, q = r == 0 ? k : (k == 0 ? 1 : (k == 1 ? 0 : 67 - k)); e[j] = (k < n) ? Eb[q * 64] : make_float2(0.f, 0.f); }
#pragma unroll
                for (int j = 0; j < 8; ++j) if (k0 + j < n) { const float nr = pr * hr - pi * hi + e[j].x, ni = pr * hi + pi * hr + e[j].y; hr = nr; hi = ni; }
            }
        }
#pragma unroll
        for (int bk = 0; bk < 8; ++bk) {
            const int blkk = r ? 7 - bk : bk;
#pragma unroll 4
            for (int sidx = 0; sidx < 16; ++sidx) {
                const int tl = r ? 15 - sidx : sidx;
                s5_step(P, ul + (16 * blkk + tl) * 16, hr, hi);
                *(unsigned*)(hs + tl * 272 + lane * 4) = pk_bf16(hr, hi);
            }
            LDS_WAIT(); asm volatile("" ::: "memory");
            f32x4v acc = {0.f, 0.f, 0.f, 0.f};
#pragma unroll
            for (int ks = 0; ks < 4; ++ks) {
                const bf16x8 a = *(const bf16x8*)(hs + fr * 272 + ks * 64 + fq * 16);
                acc = __builtin_amdgcn_mfma_f32_16x16x32_bf16(a, cf[ks], acc, 0, 0, 0);
            }
            LDS_WAIT(); asm volatile("" ::: "memory");
            if (r == 0) {
                if (bk == 0) yf[0] = acc; if (bk == 1) yf[1] = acc; if (bk == 2) yf[2] = acc; if (bk == 3) yf[3] = acc;
                if (bk == 4) yf[4] = acc; if (bk == 5) yf[5] = acc; if (bk == 6) yf[6] = acc; if (bk == 7) yf[7] = acc;
            } else {
                const f32x4v f = bk == 0 ? yf[7] : bk == 1 ? yf[6] : bk == 2 ? yf[5] : bk == 3 ? yf[4] : bk == 4 ? yf[3] : bk == 5 ? yf[2] : bk == 6 ? yf[1] : yf[0];
#pragma unroll
                for (int j = 0; j < 4; ++j) {
                    const int t = 16 * blkk + 4 * fq + j;
                    const float tot = dsk * ul[t * 16 + fr] + f[j] + acc[j], gg = gelu_tanh(tot);
                    GA[(size_t)(row0 + t) * 512 + g * 16 + fr] = bf16_1(gg);
                }
            }
        }
        LDS_WAIT(); asm volatile("" ::: "memory");
    }
}

DI void gmlp_item(unsigned char* lds, const float* U, const float* V, const float* wsp, const float* bsp, bf16* Y, int b, int n, int g, int tid, int wave, int lane) {
    typedef float f32x4v __attribute__((ext_vector_type(4)));
    unsigned char* vgT = lds;
    const int row0 = b * SEQ + n * 128, fr = lane & 15, fq = lane >> 4;
    bf16x8 wf[4];
    { const float* wp = wsp + (size_t)g * 16384 + (16 * wave + fr) * 128 + 8 * fq;
#pragma unroll
      for (int ks = 0; ks < 4; ++ks) { const f32x4v w0 = *(const f32x4v*)(wp + 32 * ks), w1 = *(const f32x4v*)(wp + 32 * ks + 4);
          u32x4 w; w.x = pk_bf16(w0[0], w0[1]); w.y = pk_bf16(w0[2], w0[3]); w.z = pk_bf16(w1[0], w1[1]); w.w = pk_bf16(w1[2], w1[3]); wf[ks] = __builtin_bit_cast(bf16x8, w); } }
    {
        float a0[16], a1[16], sm[16];
#pragma unroll
        for (int i = 0; i < 16; ++i) { const float* vp = V + (size_t)(row0 + 16 * wave + i) * 512 + g * 128; a0[i] = vp[lane]; a1[i] = vp[lane + 64]; sm[i] = a0[i] + a1[i]; }
#pragma unroll
        for (int o = 1; o < 64; o <<= 1) {
#pragma unroll
            for (int i = 0; i < 16; ++i) sm[i] += __shfl_xor(sm[i], o);
        }
#pragma unroll
        for (int i = 0; i < 16; ++i) { const float mean = sm[i] * (1.f / 128.f); a0[i] -= mean; a1[i] -= mean; sm[i] = a0[i] * a0[i] + a1[i] * a1[i]; }
#pragma unroll
        for (int o = 1; o < 64; o <<= 1) {
#pragma unroll
            for (int i = 0; i < 16; ++i) sm[i] += __shfl_xor(sm[i], o);
        }
#pragma unroll
        for (int i = 0; i < 16; ++i) { const float rstd = rsqrtf(sm[i] * (1.f / 128.f) + LN_EPS); a0[i] *= rstd; a1[i] *= rstd; }
#pragma unroll
        for (int i2 = 0; i2 < 8; ++i2) {
            *(unsigned*)(vgT + lane * 272 + (16 * wave + 2 * i2) * 2) = pk_bf16(a0[2 * i2], a0[2 * i2 + 1]);
            *(unsigned*)(vgT + (lane + 64) * 272 + (16 * wave + 2 * i2) * 2) = pk_bf16(a1[2 * i2], a1[2 * i2 + 1]);
        }
    }
    __syncthreads();
    f32x4v acc[8];
#pragma unroll
    for (int mb = 0; mb < 8; ++mb) {
        acc[mb] = (f32x4v){0.f, 0.f, 0.f, 0.f};
#pragma unroll
        for (int ks = 0; ks < 4; ++ks) {
            const bf16x8 a = *(const bf16x8*)(vgT + (16 * mb + fr) * 272 + 64 * ks + 16 * fq);
            acc[mb] = __builtin_amdgcn_mfma_f32_16x16x32_bf16(a, wf[ks], acc[mb], 0, 0, 0);
        }
    }
    const int p = 16 * wave + fr; const float bb = bsp[g * 128 + p];
#pragma unroll
    for (int mb = 0; mb < 8; ++mb) {
        const int c = 16 * mb + 4 * fq;
        const f32x4v u = *(const f32x4v*)(U + (size_t)(row0 + p) * 512 + g * 128 + c);
        *(u32x2*)(Y + (size_t)(row0 + p) * D + 512 + g * 128 + c) = (u32x2){pk_bf16(u[0] * (acc[mb][0] + bb), u[1] * (acc[mb][1] + bb)), pk_bf16(u[2] * (acc[mb][2] + bb), u[3] * (acc[mb][3] + bb))};
    }
    __syncthreads();
}

constexpr int N_PHASES = 20;
__global__ void __launch_bounds__(NTHR, 2) mega_fwd(Args args) {
    extern __shared__ __attribute__((aligned(16))) unsigned char lds[];
    cg::grid_group grid = cg::this_grid();
    const int tid = threadIdx.x, lane = tid & 63, wave = __builtin_amdgcn_readfirstlane(tid >> 6);
    const int G = gridDim.x, blk = blockIdx.x, gw = blk * NWAVES + wave, ngw = G * NWAVES;
    const int lo = args.ph_lo, hi = args.ph_hi;
    unsigned char* ws = args.ws;
    const float* const* in = args.in;
    float* XO = args.out;
    float* XC = (float*)(ws + WS_XC);
    float* MODP = (float*)(ws + WS_MODP); float* MOD = (float*)(ws + WS_MOD);
    float* ROPEC = (float*)(ws + WS_ROPE); float* ROPES = ROPEC + 2048;
    bf16* WIN0 = (bf16*)(ws + WS_WIN0); bf16* WOUT = (bf16*)(ws + WS_WOUT); bf16* W1 = (bf16*)(ws + WS_W1); bf16* W2 = (bf16*)(ws + WS_W2);
    bf16* WCD = (bf16*)(ws + WS_WCD); bf16* WGLU = (bf16*)(ws + WS_WGLU);
    bf16* H = (bf16*)(ws + WS_H); bf16* Y = (bf16*)(ws + WS_Y); bf16* ACT = (bf16*)(ws + WS_BIG);
    bf16* Qb = (bf16*)(ws + WS_Q); bf16* Kb = (bf16*)(ws + WS_K); bf16* Vt = (bf16*)(ws + WS_VT); float* FG = (float*)(ws + WS_FG);
    unsigned* TF = (unsigned*)(ws + WS_H);
    unsigned* TFC = TF + (size_t)8 * 128 * 4096;
    float* Sb = (float*)(ws + WS_S); float* Ub = (float*)(ws + WS_U); float* Vb = (float*)(ws + WS_V); bf16* GA = (bf16*)(ws + WS_GA); float* GF = (float*)(ws + WS_H);
    float2* Eb = (float2*)(ws + WS_E);
    PG8_LAS unsigned char* ldsp = (PG8_LAS unsigned char*)lds;
    volatile LAS unsigned* xst = (volatile LAS unsigned*)((LAS unsigned char*)lds + (LDS_BYTES - 64));
    if (tid < 2) xst[tid] = 0u;
    __syncthreads();
    XcdBarrier xbar; xbar.bar = (unsigned*)(ws + WS_BAR); xbar.x = 0; xbar.st = xst;
    if (hi - lo > 1) xbar = xcd_barrier_post((unsigned*)(ws + WS_BAR), xst);
#ifndef PHMASK
#define PHMASK 0xFFFFFu
#endif
#define IN(k) (((PHMASK >> ((k) > 14 ? (k) - 9 : (k))) & 1u) && lo <= (k) && (k) < hi)
#define SEAM(k) do { if ((k) + 1 < hi) { for (int rep_ = 0; rep_ < REP_SYNC; ++rep_) { xcd_barrier(xbar); } } } while (0)

    if (lo < 0) grid.sync();
    if (IN(0)) {
        for (int rep = 0; rep < REP_P01; ++rep) {
        for (int it = gw; it < 2 * 16 * 96; it += ngw) {
            const int cb = it % 96, ks = (it / 96) & 15, l = it / (96 * 16), n = cb * 64 + lane;
            const float* w = in[4] + (size_t)l * 1024 * 6144;
            float a0 = 0.f, a1 = 0.f, a2 = 0.f;
            float s0, s1, s2; { const float c0 = in[1][ks * 64 + lane], c1 = in[1][1024 + ks * 64 + lane], c2 = in[3][ks * 64 + lane];
                s0 = c0 / (1.f + __expf(-c0)); s1 = c1 / (1.f + __expf(-c1)); s2 = c2 / (1.f + __expf(-c2)); }
#pragma unroll 1
            for (int k0 = 0; k0 < 64; k0 += 16) {
                float wv[16];
#pragma unroll
                for (int kk = 0; kk < 16; ++kk) wv[kk] = w[(size_t)(ks * 64 + k0 + kk) * 6144 + n];
#pragma unroll
                for (int kk = 0; kk < 16; ++kk) { const int sl = k0 + kk;
                    a0 += __builtin_bit_cast(float, __builtin_amdgcn_readlane(__builtin_bit_cast(int, s0), sl)) * wv[kk]; a1 += __builtin_bit_cast(float, __builtin_amdgcn_readlane(__builtin_bit_cast(int, s1), sl)) * wv[kk];
                    a2 += __builtin_bit_cast(float, __builtin_amdgcn_readlane(__builtin_bit_cast(int, s2), sl)) * wv[kk]; }
            }
            float* pp = MODP + (size_t)((l * 16 + ks) * 3) * 6144 + n; pp[0] = a0; pp[6144] = a1; pp[2 * 6144] = a2;
        }
        for (int i = gw * 64 + lane; i < 2048; i += ngw * 64) { const int pos = i >> 4, f = i & 15; const float inv = powf(10000.f, -(float)f / 16.f), ang = (float)pos * inv;
            float sn, cs; sincosf(ang, &sn, &cs); ROPEC[i] = cs; ROPES[i] = sn; }
        {
            float* twt = (float*)lds + 8 * 2304;
            if (tid < 64) { twt[tid] = cospif((float)tid * (1.f / 32.f)); twt[64 + tid] = -sinpif((float)tid * (1.f / 32.f)); }
            __syncthreads();
            for (int it = gw; it < 512 * 16; it += ngw) {
                const int n = it >> 4, k = (it & 15) * 64 + lane, g = n >> 7, j = n & 127, jj = j & 63;
                const float* w = in[16] + (size_t)k * 2560 + g * 64; const float* tb = twt + (j < 64 ? 0 : 64); float a = 0.f;
#pragma unroll 4
                for (int c4 = 0; c4 < 64; c4 += 4) { const f32x4 wv = *(const f32x4*)(w + c4);
#pragma unroll
                    for (int e = 0; e < 4; ++e) a += wv[e] * tb[((c4 + e) * jj) & 63]; }
                WIN0[(size_t)n * 1024 + k] = bf16_1(a);
            }
            __syncthreads();
        }
        }
        SEAM(0);
    }
    if (IN(1)) {
        for (int rep = 0; rep < REP_P01; ++rep) {
        for (int i = gw * 64 + lane; i < 2 * 3 * 6144; i += ngw * 64) { const int n = i % 6144, v = (i / 6144) % 3, l = i / (3 * 6144);
            float a = in[5][l * 6144 + n];
            for (int ks = 0; ks < 16; ++ks) a += MODP[(size_t)((l * 16 + ks) * 3 + v) * 6144 + n];
            MOD[i] = a; }
        float* scr = (float*)lds + wave * 2304;
        constexpr int I_IN = 16 * 72, I_O = 16 * 32, I_1 = 16 * 128, I_2 = 64 * 32, I_CD = 16 * 48, I_GL = 8 * 16;
        constexpr int NIT = I_IN + 2 * I_O + 2 * I_1 + 2 * I_2 + I_CD + I_GL;
        for (int it = gw; it < NIT; it += ngw) {
            int r = it;
            if (r < I_IN) { transpose_item(in[16], 1024, 2560, WIN0, 256, scr, r / 72, 8 + r % 72, lane); continue; } r -= I_IN;
            if (r < 2 * I_O) { const int l = r / I_O; r %= I_O; transpose_item(in[6] + (size_t)l * D * D, D, D, WOUT + (size_t)l * D * D, 0, scr, r / 32, r % 32, lane); continue; } r -= 2 * I_O;
            if (r < 2 * I_1) { const int l = r / I_1; r %= I_1; transpose_item(in[10] + (size_t)l * D * FF, D, FF, W1 + (size_t)l * D * FF, 0, scr, r / 128, r % 128, lane); continue; } r -= 2 * I_1;
            if (r < 2 * I_2) { const int l = r / I_2; r %= I_2; transpose_item(in[12] + (size_t)l * D * FF, FF, D, W2 + (size_t)l * D * FF, 0, scr, r / 32, r % 32, lane); continue; } r -= 2 * I_2;
            if (r < I_CD) { transpose_item(in[22], 1024, 1536, WCD, 0, scr, r / 48, r % 48, lane); continue; } r -= I_CD;
            transpose_item(in[31], 512, 512, WGLU, 0, scr, r / 16, r % 16, lane);
        }
        }
        SEAM(1);
    }
    if (IN(2)) { for (int rep = 0; rep < REP_LN2; ++rep) ln_phase(in[0], in[2], nullptr, XC, MALL, nullptr, nullptr, MOD + 0 * 1024, MOD + 1 * 1024, H, gw, ngw, lane, MOD + 2 * 6144 + 2 * 1024, in[7]); SEAM(2); }
    if (IN(3)) {
        pg8::Gemm g{H, WIN0, MALL, 2816, D}; pg8::StaticOrder S; S.init(MALL, 2816, G, blk);
        pg8::EpiInL0 E{FG, Qb, Kb, Vt, ROPEC, ROPES, 0.125f * 1.4426950408889634f};
        for (int rep = 0; rep < REP_G3; ++rep)
        pg8::gemm_phase<pg8::EpiInL0, pg8::StaticOrder, true, true>(ldsp, g, S, E);
        SEAM(3);
    }
    if (IN(4)) {
        float lam;
        { const float d1 = wave_sum(in[17][lane] * in[18][lane]), d2 = wave_sum(in[19][lane] * in[20][lane]); lam = expf(d1) - expf(d2) + 0.2f; }
        const float* subg = in[21];
        const int nun = 768 + 24;
        for (int rep = 0; rep < REP_ATT; ++rep)
        for (int i = 0;; ++i) {
            int U;
            if (G == 256) { if (i < 3) U = (blk & 7) * 96 + (blk >> 3) + 32 * i; else { U = 768 + blk + (i - 3) * G; } }
            else U = blk + i * G;
            if (U >= nun) break;
            if (U < 768) { const int bh = U >> 6, qb = U & 63, b = bh / 6, hh = bh % 6; att::attn_unit<0>(lds, Qb, Kb, Vt, Y, b, hh, b * SEQ + qb * 128, NKEY, lam, subg, tid, wave, lane); }
            else { const int u2 = U - 768, b = u2 / 12, hh = (u2 / 2) % 6, qb = u2 & 1; att::attn_unit<0>(lds, Qb, Kb, Vt, Y, b, hh, MX + b * CTX + qb * 128, CTX, lam, subg, tid, wave, lane); }
        }
#if PROBE_ATT_VAR >= 0
        for (int i = 0; i < 3; ++i) {
            const int U = (G == 256) ? (blk & 7) * 96 + (blk >> 3) + 32 * i : blk + i * G; if (U >= 768) break;
            const int bh = U >> 6, qb = U & 63, b = bh / 6, hh = bh % 6;
            att::attn_unit<PROBE_ATT_VAR>(lds, Qb, Kb, Vt, (bf16*)(ws + WS_BIG + 108 * MiB), b, hh, b * SEQ + qb * 128, NKEY, lam, subg, tid, wave, lane, qb * 128);
        }
#endif
        for (int rep = 0; rep < REP_FFT; ++rep)
        for (int it = blk; it < 1024; it += G) {
            const int bg = (it >> 6) & 7, n2 = it & 63;
            if (it < 512) fft_step1<7>(lds, FG, TF, bg, bg & 3, (bg >> 2) * SEQ, n2, tid);
            else fft_step1<2>(lds, FG, TFC, bg, bg & 3, MX + (bg >> 2) * CTX, n2, tid);
        }
        SEAM(4);
    }
    if (IN(5)) {
        for (int rep = 0; rep < REP_FFT; ++rep)
        for (int it = blk; it < 1024 + 32; it += G) {
            if (it < 1024) { const int bg = it >> 7, k1 = it & 127; fft_step3(lds, TF, Y, bg, bg & 3, (bg >> 2) * SEQ, k1, 128, 0.0013810679320049757f, tid); }
            else { const int i2 = it - 1024, bg = i2 >> 2, k1 = i2 & 3; fft_step3(lds, TFC, Y, bg, bg & 3, MX + (bg >> 2) * CTX, k1, 4, 0.0078125f, tid); }
        }
        SEAM(5);
    }
    auto layer_tail = [&](auto LC) __attribute__((always_inline)) {
        constexpr int l = decltype(LC)::value;
        constexpr int pb = l == 0 ? 6 : 15;
        constexpr int M = l == 0 ? MALL : MX;
        const float* modl = MOD + (size_t)l * 3 * 6144;
        if constexpr (l == 1) {
            if (IN(11)) {
                pg8::Gemm g{H, WCD, MALL, 1536, D}; pg8::StaticOrder S; S.init(MALL, 1536, G, blk);
                pg8::EpiInL1 E{Sb, Ub, Vb};
                pg8::gemm_phase<pg8::EpiInL1, pg8::StaticOrder, true, true>(ldsp, g, S, E);
                SEAM(11);
            }
            if (IN(12)) {
                float* wl = (float*)lds + wave * 4096;
                for (int rep = 0; rep < REP_S5; ++rep)
                for (int it = gw; it < 2 * 32 * 2 * 66; it += ngw) s5_pass_a(wl, Sb, Eb, in, it, lane);
                __syncthreads();
                for (int rep = 0; rep < REP_GMLP; ++rep)
                for (int it = blk; it < 512; it += G) { const int g = it & 3, n = (it >> 2) & 63, b = it >> 8; gmlp_item(lds, Ub, Vb, in[33], in[34], Y, b, n, g, tid, wave, lane); }
                SEAM(12);
            }
            if (IN(13)) {
                float* wl = (float*)lds + wave * 4096;
                for (int rep = 0; rep < REP_S5; ++rep)
                for (int it = gw; it < 2 * 32 * 64; it += ngw) s5_pass_b(wl, Sb, Eb, GF, GA, in, it, lane);
                SEAM(13);
            }
            if (IN(14)) {
                pg8::Gemm g{GA, WGLU, MX, 512, 512}; pg8::StaticOrder S; S.init(MX, 512, G, blk);
                pg8::EpiGlu E{(const pg8::bf16_t*)GA, Y, in[32]};
                pg8::gemm_phase<pg8::EpiGlu, pg8::StaticOrder, true, true>(ldsp, g, S, E);
                SEAM(14);
            }
        }
        if (IN(pb)) {
            pg8::Gemm g{Y, WOUT + (size_t)l * D * D, M, D, D}; pg8::SplitOrder S; S.init(MX, D, D, G, blk, l == 0 ? 2 : 0, 8);
            pg8::EpiResGate E{l == 0 ? in[0] : XO, l == 0 ? in[2] : XC, XO, XC, modl + 2 * 1024, in[7] + l * D, ALPHA, (float*)(ws + WS_BIG), D / 8, l == 1 ? (const float*)(ws + WS_ST2) : nullptr, in[14], in[15]};
            pg8::gemm_phase<pg8::EpiResGate, pg8::SplitOrder, true, true>(ldsp, g, S, E);
            SEAM(pb);
        }
        if (IN(pb + 1)) { ln_phase(XO, XC, XO, XC, M, in[8] + l * D, in[9] + l * D, modl + 3 * 1024, modl + 4 * 1024, H, gw, ngw, lane, l == 0 ? modl + 2 * 6144 + 5 * 1024 : nullptr, in[13] + l * D, l == 0 ? (const float*)(ws + WS_BIG) : nullptr, 8, (float*)(ws + WS_ST1)); SEAM(pb + 1); }
        if (IN(pb + 2)) {
            pg8::Gemm g{H, W1 + (size_t)l * D * FF, M, FF, D}; pg8::StaticOrder S; S.init(M, FF, G, blk);
            pg8::EpiSqRelu E{ACT, FF, in[11] + l * FF};
            for (int rep = 0; rep < REP_FFN1; ++rep)
            pg8::gemm_phase<pg8::EpiSqRelu, pg8::StaticOrder, true, true>(ldsp, g, S, E);
            SEAM(pb + 2);
        }
        if (IN(pb + 3)) {
            pg8::Gemm g{ACT, W2 + (size_t)l * D * FF, M, D, FF}; pg8::SplitOrder S; S.init(MX, D, FF, G, blk, l == 0 ? 2 : 0, 16);
            pg8::EpiResGate E{XO, XC, XO, XC, modl + 5 * 1024, in[13] + l * D, ALPHA, (float*)(ws + WS_Y), FF / 16, (const float*)(ws + WS_ST1), in[8] + l * D, in[9] + l * D};
            pg8::gemm_phase<pg8::EpiResGate, pg8::SplitOrder, true, true>(ldsp, g, S, E);
            SEAM(pb + 3);
        }
        if (IN(pb + 4)) {
            if constexpr (l == 0) ln_phase(XO, XC, XO, XC, MALL, in[14], in[15], MOD + 3 * 6144 + 0 * 1024, MOD + 3 * 6144 + 1 * 1024, H, gw, ngw, lane, nullptr, nullptr, (const float*)(ws + WS_Y), 16, (float*)(ws + WS_ST2));
            else ln_phase(XO, XC, XO, XC, MX, in[14] + D, in[15] + D, nullptr, nullptr, nullptr, gw, ngw, lane);
            SEAM(pb + 4);
        }
    };
    layer_tail(std::integral_constant<int, 0>{});
    layer_tail(std::integral_constant<int, 1>{});
#undef IN
#undef SEAM
}

extern "C" void kernel_launch(void* const* d_in, const int* in_sizes, int n_in, void* d_out, int out_size, void* d_ws, size_t ws_size, hipStream_t stream) {
    static int grid = 0;
    if (grid == 0) {
        if (n_in != 35 || out_size != MX * D || ws_size < WS_END) { fprintf(stderr, "kernel_launch: unexpected problem shape (n_in %d out %d ws %zu)\n", n_in, out_size, ws_size); grid = -1; return; }
        int dev = 0, cus = 0, per_cu = 0;
        hipGetDevice(&dev); hipDeviceGetAttribute(&cus, hipDeviceAttributeMultiprocessorCount, dev);
        if (hipFuncSetAttribute((const void*)mega_fwd, hipFuncAttributeMaxDynamicSharedMemorySize, LDS_BYTES) != hipSuccess) { fprintf(stderr, "kernel_launch: hipFuncSetAttribute failed\n"); grid = -1; return; }
        if (hipOccupancyMaxActiveBlocksPerMultiprocessor(&per_cu, (const void*)mega_fwd, NTHR, LDS_BYTES) != hipSuccess || per_cu < 1) { fprintf(stderr, "kernel_launch: occupancy query says %d blocks/CU\n", per_cu); grid = -1; (void)hipGetLastError(); return; }
        grid = cus * 1;
    }
    if (grid < 0) return;
    Args a{};
    for (int i = 0; i < 35; ++i) a.in[i] = (const float*)d_in[i];
    a.out = (float*)d_out; a.ws = (unsigned char*)d_ws;
#if MK_MULTI
    for (int ph = 0; ph < N_PHASES; ++ph) { a.ph_lo = ph; a.ph_hi = ph + 1; hipLaunchKernelGGL(mega_fwd, dim3(grid), dim3(NTHR), LDS_BYTES, stream, a); }
#else
    if (hipMemsetAsync((char*)d_ws + WS_BAR, 0, XCD_BAR_WORDS * 4, stream) != hipSuccess) { fprintf(stderr, "kernel_launch: memset of the barrier words failed\n"); return; }
    a.ph_lo = 0; a.ph_hi = N_PHASES;
    void* kargs[] = {&a};
    hipError_t e = hipLaunchCooperativeKernel((const void*)mega_fwd, dim3(grid), dim3(NTHR), kargs, LDS_BYTES, stream);
    if (e != hipSuccess) fprintf(stderr, "kernel_launch: cooperative launch failed: %s (grid %d)\n", hipGetErrorString(e), grid);
#endif
}
```

```cpp
#include <hip/hip_runtime.h>
#include <hip/hip_cooperative_groups.h>
#include <cstdio>
#include <cstdint>
#include <type_traits>
namespace cg = cooperative_groups;
#ifndef MK_MULTI
#define MK_MULTI 0
#endif
#ifndef REP_ATT
#define REP_ATT 1
#endif
#ifndef REP_S5
#define REP_S5 1
#endif
#ifndef REP_G3
#define REP_G3 1
#endif
#ifndef REP_FFN1
#define REP_FFN1 1
#endif
#ifndef REP_P01
#define REP_P01 1
#endif
#ifndef REP_FFT
#define REP_FFT 1
#endif
#ifndef REP_GMLP
#define REP_GMLP 1
#endif
#ifndef REP_SYNC
#define REP_SYNC 1
#endif
#ifndef PROBE_ATT_VAR
#define PROBE_ATT_VAR -1
#endif
#ifndef REP_LN2
#define REP_LN2 1
#endif
namespace pg8 {
#define PG8_LAS __attribute__((address_space(3)))
typedef unsigned short bf16_t;
typedef short bf16x8 __attribute__((ext_vector_type(8)));
typedef float f32x4 __attribute__((ext_vector_type(4)));
typedef unsigned u32x4 __attribute__((ext_vector_type(4)));
constexpr int BM = 256, BK = 64, HALF = 128, HTB = HALF * BK * 2  , STAGE_BYTES = 8 * HTB, NXCD = 8, WGM = 4;

__host__ __device__ __forceinline__ int lds_byte(int r, int c) { const int st = (r >> 4) * 2 + (c >> 5), rr = r & 15, cc = c & 31, ob = rr * 64 + cc * 2; return st * 1024 + (ob ^ (((ob >> 9) & 1) << 5)); }
__host__ __device__ __forceinline__ void stage_rc(int b, int& R, int& C) { const int st = b / 1024, sb = b % 1024, swz = sb ^ (((sb >> 9) & 1) << 5); R = (st >> 1) * 16 + swz / 64; C = (st & 1) * 32 + (swz % 64) / 2; }
__host__ __device__ __forceinline__ int perm32(int rho) { const int n = rho >> 4, i = rho & 15; return 8 * (i >> 2) + 4 * n + (i & 3); }

struct Unit { int pm, pn; int k0 = 0, nt = 0, atomic = 0; };
struct Gemm { const bf16_t* A; const bf16_t* Bt; int M, N, K; };

struct StaticOrder {
    int nM, nN, nwg, G, c;
    __host__ __device__ void init(int M, int N, int G_, int c_) { nM = M / BM; nN = N / BM; nwg = nM * nN; G = G_; c = c_; }
    __host__ __device__ bool next(int i, Unit& u) const {
        const long L = (long)i * G + c; if (L >= nwg) return false;
        int wgid = (int)L; { const int q = nwg / NXCD, r = nwg % NXCD, xcd = wgid % NXCD, off = wgid / NXCD; wgid = (xcd < r ? xcd * (q + 1) : r * (q + 1) + (xcd - r) * q) + off; }
        const int nig = WGM * nN, gid = wgid / nig, fm = gid * WGM, gsz = (nM - fm) < WGM ? (nM - fm) : WGM;
        u.pm = fm + ((wgid % nig) % gsz); u.pn = (wgid % nig) / gsz; return true;
    }
    __device__ __forceinline__ void a_ready(const Unit&) const {}
    __device__ __forceinline__ void done(const Unit&) const {}
};

__device__ __forceinline__ unsigned cvt_pk_bf16(float lo, float hi) { unsigned r; asm volatile("v_cvt_pk_bf16_f32 %0, %1, %2" : "=v"(r) : "v"(lo), "v"(hi)); return r; }
struct SplitOrder {
    StaticOrder base; int G, c, nN, nsplit, kslice, nctx;
    __host__ __device__ void init(int Mx, int N, int K, int G_, int c_, int ctx_tiles_m, int nsplit_) { base.init(Mx, N, G_, c_); G = G_; c = c_; nN = N / BM; nsplit = nsplit_; kslice = K / nsplit_; nctx = ctx_tiles_m * nN * nsplit_; }
    __host__ __device__ bool next(int i, Unit& u) const {
        const long L = (long)i * G + c;
        if (L < base.nwg) { const bool ok = base.next(i, u); u.k0 = 0; u.nt = 0; u.atomic = 0; return ok; }
        const int j = (int)(L - base.nwg); if (j >= nctx) return false;
        const int kp = j % nsplit, t = j / nsplit;
        u.pn = t % nN; u.pm = base.nM + t / nN; u.k0 = kp * kslice; u.nt = kslice / BK; u.atomic = 1; return true;
    }
    __device__ __forceinline__ void a_ready(const Unit&) const {}
    __device__ __forceinline__ void done(const Unit&) const {}
};

constexpr int MX = 16384;
constexpr int NKEY = 8448;
typedef __bf16 bf16x2_t __attribute__((ext_vector_type(2)));
typedef float f32x2_t __attribute__((ext_vector_type(2)));
__device__ __forceinline__ unsigned pk_bf16(float lo, float hi) { f32x2_t v = {lo, hi}; bf16x2_t b = __builtin_convertvector(v, bf16x2_t); return __builtin_bit_cast(unsigned, b); }
__device__ __forceinline__ unsigned short bf16_1(float x) { return (unsigned short)(pk_bf16(x, 0.f) & 0xffffu); }
typedef unsigned u32x2 __attribute__((ext_vector_type(2)));

struct EpiInL0 {
    static constexpr bool PERM = false, AFTER_DRAIN = false;
    float* FG; bf16_t* Q; bf16_t* Kb; bf16_t* Vt; const float* ropeC; const float* ropeS; float qscale;
    __device__ __forceinline__ void operator()(const f32x4 (&acc)[2][2][4][2], const Unit& u, int wr, int wc, int fr, int fq) const {
        const int pn = u.pn;
#pragma unroll
        for (int ai = 0; ai < 2; ++ai)
#pragma unroll
            for (int m = 0; m < 4; ++m) {
                const int row = u.pm * BM + ai * HALF + wr * 64 + m * 16 + fr;
                const bool isx = row < MX;
                const int b = isx ? (row >> 13) : ((row - MX) >> 8), n = isx ? (row & 8191) : ((row - MX) & 255);
                const int key = isx ? 256 + n : n;
#pragma unroll
                for (int bj = 0; bj < 2; ++bj) {
                    const int colb = pn * BM + bj * HALF + wc * 32;
                    f32x4 v0 = acc[ai][bj][m][0], v1 = acc[ai][bj][m][1];
                    if (pn < 2) {
                        *(f32x4*)(FG + (size_t)row * 512 + colb + 4 * fq) = v0; *(f32x4*)(FG + (size_t)row * 512 + colb + 16 + 4 * fq) = v1;
                    } else if (pn < 8) {
                        if (isx) {
                            const int pos = ((colb >> 5) & 1) ? (n & 63) : (n >> 6);
                            const f32x4 c = *(const f32x4*)(ropeC + pos * 16 + 4 * fq), s = *(const f32x4*)(ropeS + pos * 16 + 4 * fq);
                            const f32x4 o0 = v0 * c - v1 * s, o1 = v1 * c + v0 * s; v0 = o0; v1 = o1;
                        }
                        if (pn < 5) {
                            v0 = v0 * qscale; v1 = v1 * qscale;
                            bf16_t* d = Q + (size_t)row * 768 + (colb - 512) + 4 * fq;
                            *(u32x2*)d = (u32x2){pk_bf16(v0[0], v0[1]), pk_bf16(v0[2], v0[3])}; *(u32x2*)(d + 16) = (u32x2){pk_bf16(v1[0], v1[1]), pk_bf16(v1[2], v1[3])};
                        } else {
                            const int ck = colb - 1280 + 4 * fq;
                            const int kk = key & 63, dd = ck & 63;
                            bf16_t* d = Kb + ((size_t)(b * 6 + (ck >> 7)) * 132 + (key >> 6)) * 16384 + (((ck >> 6) & 1) * 64 + kk) * 64 + ((((dd >> 3) ^ ((kk >> 1) & 7)) << 3) | (dd & 7));
                            *(u32x2*)d = (u32x2){pk_bf16(v0[0], v0[1]), pk_bf16(v0[2], v0[3])};
                            bf16_t* d2 = Kb + ((size_t)(b * 6 + (ck >> 7)) * 132 + (key >> 6)) * 16384 + (((ck >> 6) & 1) * 64 + kk) * 64 + (((((dd + 16) >> 3) ^ ((kk >> 1) & 7)) << 3) | (dd & 7));
                            *(u32x2*)d2 = (u32x2){pk_bf16(v1[0], v1[1]), pk_bf16(v1[2], v1[3])};
                        }
                    } else {
                        const int e0 = colb - 2048 + 4 * fq, hh = e0 >> 7, e = e0 & 127;
                        const int kk = key & 63, pos = (kk & 48) + 8 * ((kk >> 2) & 1) + 4 * ((kk >> 3) & 1) + (kk & 3);
                        bf16_t* d = Kb + ((size_t)(b * 6 + hh) * 132 + (key >> 6)) * 16384 + 8192;
#pragma unroll
                        for (int j = 0; j < 4; ++j) {
                            const int ea = e + j, eb2 = e + 16 + j;
                            d[ea * 64 + ((((pos >> 3) ^ ((ea >> 1) & 7)) << 3) | (pos & 7))] = bf16_1(v0[j]);
                            d[eb2 * 64 + ((((pos >> 3) ^ ((eb2 >> 1) & 7)) << 3) | (pos & 7))] = bf16_1(v1[j]);
                        }
                    }
                }
            }
    }
};

struct EpiResGate {
    static constexpr bool PERM = true, AFTER_DRAIN = false;
    const float* res_x; const float* res_c; float* out_x; float* out_c; const float* gate; const float* bias; float alpha; float* part; int kslice;
    const float* stats; const float* lng; const float* lnb;
    __device__ __forceinline__ void operator()(const f32x4 (&acc)[2][2][4][2], const Unit& u, int wr, int wc, int fr, int fq) const {
#pragma unroll
        for (int ai = 0; ai < 2; ++ai)
#pragma unroll
            for (int m = 0; m < 4; ++m) {
                const int row = u.pm * BM + ai * HALF + wr * 64 + m * 16 + fr;
                const bool isx = row < MX;
                const int v = isx ? (row >> 13) : 2;
                const float* rp = isx ? res_x + (size_t)row * 1024 : res_c + (size_t)(row - MX) * 1024;
                float* op = isx ? out_x + (size_t)row * 1024 : out_c + (size_t)(row - MX) * 1024;
                const float* gp = gate + v * 6144;
                float mu = 0.f, rs = 1.f; const bool dl = stats && isx;
                if (dl) { mu = stats[2 * row]; rs = stats[2 * row + 1]; }
#pragma unroll
                for (int bj = 0; bj < 2; ++bj) {
                    const int c0 = u.pn * BM + bj * HALF + wc * 32 + 8 * fq;
#pragma unroll
                    for (int n = 0; n < 2; ++n) {
                        const int c = c0 + 4 * n;
                        const f32x4 g = *(const f32x4*)(gp + c);
                        if (u.atomic) {
                            *(f32x4*)(part + ((size_t)(u.k0 / kslice) * 512 + (row - MX)) * 1024 + c) = g * acc[ai][bj][m][n];
                        } else {
                            f32x4 r = *(const f32x4*)(rp + c); const f32x4 bb = *(const f32x4*)(bias + c);
                            if (dl) r = (r - mu) * rs * *(const f32x4*)(lng + c) + *(const f32x4*)(lnb + c);
                            *(f32x4*)(op + c) = r * alpha + g * (acc[ai][bj][m][n] + bb);
                        }
                    }
                }
            }
    }
};

struct EpiSqRelu {
    static constexpr bool PERM = true, AFTER_DRAIN = false;
    bf16_t* O; int ldc; const float* bias;
    __device__ __forceinline__ void operator()(const f32x4 (&acc)[2][2][4][2], const Unit& u, int wr, int wc, int fr, int fq) const {
#pragma unroll
        for (int ai = 0; ai < 2; ++ai)
#pragma unroll
            for (int m = 0; m < 4; ++m) {
                const int row = u.pm * BM + ai * HALF + wr * 64 + m * 16 + fr;
#pragma unroll
                for (int bj = 0; bj < 2; ++bj) {
                    const int c0 = u.pn * BM + bj * HALF + wc * 32 + 8 * fq;
                    f32x4 v0 = acc[ai][bj][m][0] + *(const f32x4*)(bias + c0), v1 = acc[ai][bj][m][1] + *(const f32x4*)(bias + c0 + 4);
#pragma unroll
                    for (int j = 0; j < 4; ++j) { const float a = fmaxf(v0[j], 0.f), c = fmaxf(v1[j], 0.f); v0[j] = a * a; v1[j] = c * c; }
                    u32x4 w; w.x = pk_bf16(v0[0], v0[1]); w.y = pk_bf16(v0[2], v0[3]); w.z = pk_bf16(v1[0], v1[1]); w.w = pk_bf16(v1[2], v1[3]);
                    *(u32x4*)(O + (size_t)row * ldc + c0) = w;
                }
            }
    }
};

struct EpiInL1 {
    static constexpr bool PERM = true, AFTER_DRAIN = false;
    float* S; float* U; float* V;
    __device__ __forceinline__ void operator()(const f32x4 (&acc)[2][2][4][2], const Unit& u, int wr, int wc, int fr, int fq) const {
        const int t = u.pn >> 1;
        float* base = S + (size_t)t * (33u << 18);
#pragma unroll
        for (int ai = 0; ai < 2; ++ai)
#pragma unroll
            for (int m = 0; m < 4; ++m) {
                const int row = u.pm * BM + ai * HALF + wr * 64 + m * 16 + fr;
                if (t != 0 && row >= MX) continue;
#pragma unroll
                for (int bj = 0; bj < 2; ++bj) {
                    const int c0 = (u.pn & 1) * BM + bj * HALF + wc * 32 + 8 * fq;
                    *(f32x4*)(base + (size_t)row * 512 + c0) = acc[ai][bj][m][0]; *(f32x4*)(base + (size_t)row * 512 + c0 + 4) = acc[ai][bj][m][1];
                }
            }
    }
};

struct EpiGlu {
    static constexpr bool PERM = true, AFTER_DRAIN = false;
    const bf16_t* GAp; bf16_t* Y; const float* bias;
    __device__ __forceinline__ void operator()(const f32x4 (&acc)[2][2][4][2], const Unit& u, int wr, int wc, int fr, int fq) const {
#pragma unroll
        for (int ai = 0; ai < 2; ++ai)
#pragma unroll
            for (int m = 0; m < 4; ++m) {
                const int row = u.pm * BM + ai * HALF + wr * 64 + m * 16 + fr;
#pragma unroll
                for (int bj = 0; bj < 2; ++bj) {
                    const int c0 = u.pn * BM + bj * HALF + wc * 32 + 8 * fq;
                    f32x4 v0 = acc[ai][bj][m][0] + *(const f32x4*)(bias + c0), v1 = acc[ai][bj][m][1] + *(const f32x4*)(bias + c0 + 4);
                    const u32x4 gw = *(const u32x4*)(GAp + (size_t)row * 512 + c0);
                    const f32x4 g0 = {__builtin_bit_cast(float, gw.x << 16), __builtin_bit_cast(float, gw.x & 0xffff0000u), __builtin_bit_cast(float, gw.y << 16), __builtin_bit_cast(float, gw.y & 0xffff0000u)};
                    const f32x4 g1 = {__builtin_bit_cast(float, gw.z << 16), __builtin_bit_cast(float, gw.z & 0xffff0000u), __builtin_bit_cast(float, gw.w << 16), __builtin_bit_cast(float, gw.w & 0xffff0000u)};
#pragma unroll
                    for (int j = 0; j < 4; ++j) { v0[j] = g0[j] * __builtin_amdgcn_rcpf(1.f + __expf(-v0[j])); v1[j] = g1[j] * __builtin_amdgcn_rcpf(1.f + __expf(-v1[j])); }
                    u32x4 w; w.x = pk_bf16(v0[0], v0[1]); w.y = pk_bf16(v0[2], v0[3]); w.z = pk_bf16(v1[0], v1[1]); w.w = pk_bf16(v1[2], v1[3]);
                    *(u32x4*)(Y + (size_t)row * 1024 + c0) = w;
                }
            }
    }
};
template <class Epi, class Sched, bool ALIGN_EPI = false, bool SP2 = false>
__device__ __forceinline__ void gemm_phase(PG8_LAS unsigned char* lds, const Gemm g, const Sched& S, const Epi& E) {
    int tid_o = threadIdx.x; asm volatile("" : "+v"(tid_o));
    const int tid = tid_o, wid = __builtin_amdgcn_readfirstlane(tid >> 6), lane = tid & 63, wr = wid >> 2, wc = wid & 3, fr = lane & 15, fq = lane >> 4;
    const int K = g.K, nt = K / BK;
    unsigned voffA[2], voffB[2];
#pragma unroll
    for (int i = 0; i < 2; ++i) { int R, C; stage_rc(tid * 16 + i * 8192, R, C); const int Rb = Epi::PERM ? ((R & ~31) + perm32(R & 31)) : R;
        voffA[i] = (unsigned)(R * K + C) * 2u; voffB[i] = (unsigned)(Rb * K + C) * 2u; }
    const size_t kstep = (size_t)(BK * 2);
    const size_t hstep = (size_t)HALF * K * 2;
    const size_t tstep = 2 * hstep;
    const unsigned ldsw = (unsigned)wid * 1024u;
    const int aoff = lds_byte(wr * 64 + fr, fq * 8), boff = lds_byte(wc * 32 + fr, fq * 8);
#define PG8_SA(b, h) (((b) * 2 + (h)) * HTB)
#define PG8_SB(b, h) ((4 + (b) * 2 + (h)) * HTB)
#define PG8_STAGE(bufoff, gbase, voff) do { _Pragma("unroll") for (int _i = 0; _i < 2; ++_i) \
        __builtin_amdgcn_global_load_lds((const unsigned*)((const char*)(gbase) + (voff)[_i]), (PG8_LAS unsigned*)(lds + (bufoff) + ldsw + _i * 8192), 16, 0, 0); } while (0)
#define PG8_LDA(dst, b, h) do { _Pragma("unroll") for (int m = 0; m < 4; ++m) _Pragma("unroll") for (int k = 0; k < 2; ++k) dst[m][k] = *(const PG8_LAS bf16x8*)(lds + PG8_SA(b, h) + aoff + m * 2048 + k * 1024); } while (0)
#define PG8_LDB(dst, b, h) do { _Pragma("unroll") for (int n = 0; n < 2; ++n) _Pragma("unroll") for (int k = 0; k < 2; ++k) dst[n][k] = *(const PG8_LAS bf16x8*)(lds + PG8_SB(b, h) + boff + n * 2048 + k * 1024); } while (0)
#define PG8_MMA(ai, bj, At, Bt) do { __builtin_amdgcn_s_setprio(1); _Pragma("unroll") for (int m = 0; m < 4; ++m) _Pragma("unroll") for (int n = 0; n < 2; ++n) _Pragma("unroll") for (int k = 0; k < 2; ++k) \
        acc[ai][bj][m][n] = __builtin_amdgcn_mfma_f32_16x16x32_bf16(Bt[n][k], At[m][k], acc[ai][bj][m][n], 0, 0, 0); __builtin_amdgcn_s_setprio(0); } while (0)
#define PG8_WAIT_V(n) asm volatile("s_waitcnt vmcnt(" #n ")" ::: "memory")
#define PG8_WAIT_L(n) asm volatile("s_waitcnt lgkmcnt(" #n ")" ::: "memory")
#define PG8_BAR __builtin_amdgcn_s_barrier()
#define PG8_SCHED __builtin_amdgcn_sched_barrier(0)
    Unit cur, nxt; int ui = 0;
    if (!S.next(0, cur)) return;
    f32x4 acc[2][2][4][2];
#pragma unroll
    for (int a = 0; a < 2; ++a)
#pragma unroll
        for (int b = 0; b < 2; ++b)
#pragma unroll
            for (int m = 0; m < 4; ++m)
#pragma unroll
                for (int n = 0; n < 2; ++n) acc[a][b][m][n] = (f32x4){0.f, 0.f, 0.f, 0.f};
    bf16x8 At[4][2], B0[2][2], B1[2][2];
    const char* cA = (const char*)g.A + (size_t)cur.pm * tstep + (size_t)cur.k0 * 2; const char* cB = (const char*)g.Bt + (size_t)cur.pn * tstep + (size_t)cur.k0 * 2;
    S.a_ready(cur);
    if constexpr (SP2) {
        PG8_STAGE(PG8_SB(0, 0), cB, voffB); PG8_STAGE(PG8_SB(0, 1), cB + hstep, voffB); PG8_STAGE(PG8_SA(0, 0), cA, voffA); PG8_STAGE(PG8_SA(0, 1), cA + hstep, voffA);
        if (wr == 1) PG8_BAR;
        PG8_WAIT_V(2); PG8_BAR;
        PG8_STAGE(PG8_SB(1, 0), cB + kstep, voffB); PG8_STAGE(PG8_SA(1, 0), cA + kstep, voffA); PG8_STAGE(PG8_SB(1, 1), cB + hstep + kstep, voffB);
        PG8_WAIT_V(6); PG8_BAR;
    } else {
        PG8_STAGE(PG8_SB(0, 0), cB, voffB); PG8_STAGE(PG8_SA(0, 0), cA, voffA); PG8_STAGE(PG8_SB(0, 1), cB + hstep, voffB); PG8_STAGE(PG8_SA(0, 1), cA + hstep, voffA);
        if (wr == 1) PG8_BAR;
        PG8_WAIT_V(4); PG8_BAR;
        PG8_STAGE(PG8_SB(1, 0), cB + kstep, voffB); PG8_STAGE(PG8_SA(1, 0), cA + kstep, voffA); PG8_STAGE(PG8_SB(1, 1), cB + hstep + kstep, voffB);
        PG8_WAIT_V(6); PG8_BAR;
    }
    for (;;) {
        const bool has_next = S.next(ui + 1, nxt);
        const char* nA = has_next ? (const char*)g.A + (size_t)nxt.pm * tstep + (size_t)nxt.k0 * 2 : cA; const char* nB = has_next ? (const char*)g.Bt + (size_t)nxt.pn * tstep + (size_t)nxt.k0 * 2 : cB;
        const int ntc = cur.nt ? cur.nt : nt;
        for (int t = 0; t < ntc; t += 2) {
            const bool last = (t == ntc - 2);
            const char* a1 = cA + (size_t)(t + 1) * kstep;
            const char* a2 = last ? nA : cA + (size_t)(t + 2) * kstep; const char* b2 = last ? nB : cB + (size_t)(t + 2) * kstep;
            const char* a3 = a2 + kstep; const char* b3 = b2 + kstep;
            if (last && has_next) S.a_ready(nxt);
            if constexpr (SP2) {
            PG8_LDB(B0, 0, 0); PG8_LDB(B1, 0, 1); PG8_SCHED; PG8_LDA(At, 0, 0); PG8_STAGE(PG8_SA(1, 1), a1 + hstep, voffA);
            PG8_WAIT_V(8); PG8_WAIT_L(0); PG8_BAR; PG8_MMA(0, 0, At, B0); PG8_MMA(0, 1, At, B1); PG8_BAR; PG8_SCHED;
            PG8_LDA(At, 0, 1); PG8_STAGE(PG8_SB(0, 0), b2, voffB); PG8_STAGE(PG8_SB(0, 1), b2 + hstep, voffB); PG8_STAGE(PG8_SA(0, 0), a2, voffA);
            PG8_WAIT_V(8); PG8_WAIT_L(0); PG8_BAR; PG8_MMA(1, 0, At, B0); PG8_MMA(1, 1, At, B1); PG8_BAR; PG8_SCHED;
            PG8_LDB(B0, 1, 0); PG8_LDB(B1, 1, 1); PG8_SCHED; PG8_LDA(At, 1, 0); PG8_STAGE(PG8_SA(0, 1), a2 + hstep, voffA);
            PG8_WAIT_V(8); PG8_WAIT_L(0); PG8_BAR; PG8_MMA(0, 0, At, B0); PG8_MMA(0, 1, At, B1); PG8_BAR; PG8_SCHED;
            PG8_LDA(At, 1, 1); PG8_STAGE(PG8_SB(1, 0), b3, voffB); PG8_STAGE(PG8_SB(1, 1), b3 + hstep, voffB); PG8_STAGE(PG8_SA(1, 0), a3, voffA);
            PG8_WAIT_V(8); PG8_WAIT_L(0); PG8_BAR; PG8_MMA(1, 0, At, B0); PG8_MMA(1, 1, At, B1); PG8_BAR; PG8_SCHED;
            } else {
            PG8_LDB(B0, 0, 0); PG8_SCHED; PG8_LDA(At, 0, 0); PG8_STAGE(PG8_SA(1, 1), a1 + hstep, voffA);
            PG8_WAIT_L(8); PG8_BAR; PG8_WAIT_L(0); PG8_MMA(0, 0, At, B0); PG8_BAR; PG8_SCHED;
            PG8_LDB(B1, 0, 1); PG8_STAGE(PG8_SB(0, 0), b2, voffB);
            PG8_BAR; PG8_WAIT_L(0); PG8_MMA(0, 1, At, B1); PG8_BAR;
            PG8_LDA(At, 0, 1); PG8_STAGE(PG8_SA(0, 0), a2, voffA);
            PG8_BAR; PG8_WAIT_L(0); PG8_MMA(1, 0, At, B0); PG8_BAR; PG8_SCHED;
            PG8_STAGE(PG8_SB(0, 1), b2 + hstep, voffB);
            PG8_WAIT_V(6); PG8_BAR; PG8_MMA(1, 1, At, B1); PG8_BAR;
            PG8_LDB(B0, 1, 0); PG8_SCHED; PG8_LDA(At, 1, 0); PG8_STAGE(PG8_SA(0, 1), a2 + hstep, voffA);
            PG8_WAIT_L(8); PG8_BAR; PG8_WAIT_L(0); PG8_MMA(0, 0, At, B0); PG8_BAR; PG8_SCHED;
            PG8_LDB(B1, 1, 1); PG8_STAGE(PG8_SB(1, 0), b3, voffB);
            PG8_BAR; PG8_WAIT_L(0); PG8_MMA(0, 1, At, B1); PG8_BAR;
            PG8_LDA(At, 1, 1); PG8_STAGE(PG8_SA(1, 0), a3, voffA);
            PG8_BAR; PG8_WAIT_L(0); PG8_MMA(1, 0, At, B0); PG8_BAR; PG8_SCHED;
            PG8_STAGE(PG8_SB(1, 1), b3 + hstep, voffB);
            PG8_WAIT_V(6); PG8_BAR; PG8_MMA(1, 1, At, B1); PG8_BAR;
            }
        }
        if constexpr (ALIGN_EPI) { if (wr == 0) PG8_BAR; }
        if constexpr (!Epi::AFTER_DRAIN) { E(acc, cur, wr, wc, fr, fq); S.done(cur); }
        if (!has_next) break;
#pragma unroll
        for (int a = 0; a < 2; ++a)
#pragma unroll
            for (int b = 0; b < 2; ++b)
#pragma unroll
                for (int m = 0; m < 4; ++m)
#pragma unroll
                    for (int n = 0; n < 2; ++n) acc[a][b][m][n] = (f32x4){0.f, 0.f, 0.f, 0.f};
        cur = nxt; cA = nA; cB = nB; ++ui;
        if constexpr (ALIGN_EPI) { if (wr == 1) PG8_BAR; }
    }
    PG8_WAIT_V(0);
    if constexpr (!ALIGN_EPI) { if (wr == 0) PG8_BAR; }
    PG8_BAR;
    if constexpr (Epi::AFTER_DRAIN) { E.fused(acc, cur, wr, wc, fr, fq, lds, wid, lane); S.done(cur); }
#undef PG8_SA
#undef PG8_SB
#undef PG8_STAGE
#undef PG8_LDA
#undef PG8_LDB
#undef PG8_MMA
#undef PG8_WAIT_V
#undef PG8_WAIT_L
#undef PG8_BAR
#undef PG8_SCHED
}
}

#define DI __device__ __forceinline__
#define LAS __attribute__((address_space(3)))
typedef unsigned short bf16;
typedef float f32x4 __attribute__((ext_vector_type(4)));
typedef float f32x16 __attribute__((ext_vector_type(16)));
typedef short bf16x8 __attribute__((ext_vector_type(8)));
typedef short s16x4 __attribute__((ext_vector_type(4)));
typedef unsigned u32x4 __attribute__((ext_vector_type(4)));
typedef unsigned u32x2 __attribute__((ext_vector_type(2)));
using pg8::pk_bf16; using pg8::bf16_1;

constexpr int NWAVES = 8, NTHR = 512;
constexpr int LDS_BYTES = 147456;
constexpr int D = 1024, MX = 16384, MC = 512, MALL = MX + MC, SEQ = 8192, CTX = 256, NKEY = 8448, FF = 4096;
constexpr float LN_EPS = 1e-5f;
constexpr float ALPHA = 1.41421356237309515f;
constexpr size_t MiB = 1u << 20;
constexpr size_t WS_MODP = 0;
constexpr size_t WS_MOD = 2 * MiB + 256 * 1024;
constexpr size_t WS_ROPE = 2 * MiB + 512 * 1024;
constexpr size_t WS_ST1 = 7 * MiB + 256 * 1024, WS_ST2 = WS_ST1 + 128 * 1024;
constexpr size_t WS_BAR = 2 * MiB + 768 * 1024;
constexpr size_t WS_E = 3 * MiB;
constexpr size_t WS_XC = 8 * MiB;
constexpr size_t WS_WIN0 = 10 * MiB;
constexpr size_t WS_WOUT = 16 * MiB;
constexpr size_t WS_W1 = 20 * MiB;
constexpr size_t WS_W2 = 36 * MiB;
constexpr size_t WS_WCD = 52 * MiB;
constexpr size_t WS_WGLU = 55 * MiB;
constexpr size_t WS_H = 56 * MiB;
constexpr size_t WS_Y = 89 * MiB;
constexpr size_t WS_BIG = 122 * MiB;
constexpr size_t WS_Q = WS_BIG, WS_K = WS_BIG + 25 * MiB, WS_VT = WS_BIG + 50 * MiB, WS_FG = WS_BIG + 75 * MiB;
constexpr size_t WS_S = WS_BIG, WS_U = WS_BIG + 33 * MiB, WS_V = WS_BIG + 66 * MiB, WS_GA = WS_BIG + 99 * MiB;
constexpr size_t WS_END = 254 * MiB;

struct Args { const float* in[35]; float* out; unsigned char* ws; int ph_lo, ph_hi; };

DI float wave_sum(float v) {
#pragma unroll
    for (int o = 1; o < 64; o <<= 1) v += __shfl_xor(v, o);
    return v;
}
#define LDS_WAIT() asm volatile("s_waitcnt lgkmcnt(0)" ::: "memory")

DI void transpose_item(const float* W, int K, int N, bf16* WT, int row_off, float* scr, int kb, int nb, int lane) {
    const int k0 = 64 * kb, n0 = 32 * nb;
    float tv[32];
#pragma unroll
    for (int i = 0; i < 32; ++i) { const int kk = 2 * i + (lane >> 5); tv[i] = W[(size_t)(k0 + kk) * N + n0 + (lane & 31)]; }
#pragma unroll
    for (int i = 0; i < 32; ++i) { const int kk = 2 * i + (lane >> 5); scr[kk * 33 + (lane & 31)] = tv[i]; }
    LDS_WAIT(); asm volatile("" ::: "memory");
    const int c = lane & 7;
#pragma unroll
    for (int j = 0; j < 4; ++j) { const int n = (lane >> 3) + 8 * j; const float* s = scr + (8 * c) * 33 + n;
        u32x4 o; o.x = pk_bf16(s[0 * 33], s[1 * 33]); o.y = pk_bf16(s[2 * 33], s[3 * 33]); o.z = pk_bf16(s[4 * 33], s[5 * 33]); o.w = pk_bf16(s[6 * 33], s[7 * 33]);
        *(u32x4*)(WT + (size_t)(row_off + n0 + n) * K + k0 + 8 * c) = o; }
    LDS_WAIT(); asm volatile("" ::: "memory");
}

#define XB_TMO      128
#define XB_XCNT(j)  (256  + 64 * (j))
#define XB_XSUB(j)  (1280 + 64 * (j))
#define XB_XGEN(j)  (2304 + 64 * (j))
#define XB_TOP      3328
#define XB_TOPGEN   3392
#define XCD_BAR_WORDS 3456
#define XB_SPIN_CAP (1u << 18)

__device__ __forceinline__ unsigned xb_ld(unsigned* p)              { return __hip_atomic_load(p, __ATOMIC_RELAXED, __HIP_MEMORY_SCOPE_AGENT); }
__device__ __forceinline__ unsigned xb_add(unsigned* p, unsigned v) { return __hip_atomic_fetch_add(p, v, __ATOMIC_RELAXED, __HIP_MEMORY_SCOPE_AGENT); }
__device__ __forceinline__ unsigned xb_xcc_id() { return (unsigned)__builtin_amdgcn_s_getreg((3 << 11) | 20) & 0xFu; }
#define XB_SPIN(cond, bar) do { unsigned _sp = 0; while (cond) { __builtin_amdgcn_s_sleep(1); \
    if ((++_sp & 255u) == 0u) { if (xb_ld(&(bar)[XB_TMO])) break; if (_sp > XB_SPIN_CAP) { atomicAdd(&(bar)[XB_TMO], 1u); break; } } } } while (0)

struct XcdBarrier {
    unsigned* bar; unsigned x;
    volatile LAS unsigned* st;
};

__device__ __forceinline__ XcdBarrier xcd_barrier_post(unsigned* bar, volatile LAS unsigned* st) {
    XcdBarrier b; b.bar = bar; b.x = xb_xcc_id(); b.st = st;
    if (threadIdx.x == 0) (void)xb_add(&bar[XB_XCNT(b.x)], 1u);
    return b;
}
__device__ __forceinline__ void xcd_barrier_complete(unsigned* bar, unsigned x, unsigned& nloc, unsigned& nx) {
    const unsigned G = gridDim.x * gridDim.y * gridDim.z;
    unsigned sum, cnt, mine, sp = 0u;
    for (;;) {
        sum = 0u; cnt = 0u; mine = 0u;
#pragma unroll
        for (unsigned j = 0; j < 16; ++j) { const unsigned c = xb_ld(&bar[XB_XCNT(j)]); sum += c; cnt += (c > 0u) ? 1u : 0u; mine = (j == x) ? c : mine; }
        if (sum == G) break;
        __builtin_amdgcn_s_sleep(1);
        if ((++sp & 255u) == 0u) { if (xb_ld(&bar[XB_TMO])) break; if (sp > XB_SPIN_CAP) { atomicAdd(&bar[XB_TMO], 1u); break; } }
    }
    nloc = mine > 0u ? mine : 1u; nx = cnt > 0u ? cnt : 1u;
}

__device__ __forceinline__ void xcd_barrier(const XcdBarrier& b) {
    asm volatile("s_waitcnt vmcnt(0)" ::: "memory");
    __syncthreads();
    if (threadIdx.x == 0) {
        unsigned* bar = b.bar;
        __builtin_amdgcn_s_waitcnt(0);
        unsigned nloc = b.st[0], nx = b.st[1];
        if (nloc == 0u) { xcd_barrier_complete(bar, b.x, nloc, nx); b.st[0] = nloc; b.st[1] = nx; }
        const unsigned old = xb_add(&bar[XB_XSUB(b.x)], 1u);
        const unsigned gen = old / nloc;
        if (old + 1u == (gen + 1u) * nloc) {
            __builtin_amdgcn_fence(__ATOMIC_RELEASE, "agent");
            asm volatile("s_waitcnt vmcnt(0)" ::: "memory");
            const unsigned og = xb_add(&bar[XB_TOP], 1u);
            const unsigned tg = og / nx;
            if (og + 1u == (tg + 1u) * nx) xb_add(&bar[XB_TOPGEN], 1u);
            else XB_SPIN(xb_ld(&bar[XB_TOPGEN]) == tg, bar);
            __builtin_amdgcn_fence(__ATOMIC_ACQUIRE, "agent");
            xb_add(&bar[XB_XGEN(b.x)], 1u);
            asm volatile("s_waitcnt vmcnt(0)" ::: "memory");
        } else {
            XB_SPIN(xb_ld(&bar[XB_XGEN(b.x)]) == gen, bar);
            __builtin_amdgcn_fence(__ATOMIC_ACQUIRE, "agent");
            asm volatile("s_waitcnt vmcnt(0)" ::: "memory");
        }
    }
    __syncthreads();
}

DI void ln_phase(const float* src_x, const float* src_c, float* dst_x, float* dst_c, int nrows, const float* g, const float* bta,
                 const float* mod_sh, const float* mod_sc, bf16* H, int gw, int ngw, int lane, const float* cg = nullptr, const float* cb = nullptr, const float* part = nullptr, int nparts = 0, float* stats = nullptr) {
    for (int row = gw; row < nrows; row += ngw) {
        const bool isx = row < MX; const int v = isx ? (row >> 13) : 2;
        const float* sp = isx ? src_x + (size_t)row * D : src_c + (size_t)(row - MX) * D;
        f32x4 x[4]; float s = 0.f;
#pragma unroll
        for (int j = 0; j < 4; ++j) { x[j] = *(const f32x4*)(sp + (lane + 64 * j) * 4);
            if (part && !isx) for (int k = 0; k < nparts; ++k) x[j] = x[j] + *(const f32x4*)(part + ((size_t)k * 512 + (row - MX)) * D + (lane + 64 * j) * 4);
            s += (x[j][0] + x[j][1]) + (x[j][2] + x[j][3]); }
        float mean = wave_sum(s) * (1.f / D), s2 = 0.f;
#pragma unroll
        for (int j = 0; j < 4; ++j) { x[j] = x[j] - mean; s2 += (x[j][0] * x[j][0] + x[j][1] * x[j][1]) + (x[j][2] * x[j][2] + x[j][3] * x[j][3]); }
        float rstd = rsqrtf(wave_sum(s2) * (1.f / D) + LN_EPS);
        if (!g && cg && !isx) {
            float* dp = dst_c + (size_t)(row - MX) * D;
#pragma unroll
            for (int j = 0; j < 4; ++j) { const int c = (lane + 64 * j) * 4; *(f32x4*)(dp + c) = (x[j] + mean) * ALPHA + *(const f32x4*)(cg + c) * *(const f32x4*)(cb + c); }
        }
        if (g) {
            if (stats && isx && lane == 0) { stats[2 * row] = mean; stats[2 * row + 1] = rstd; }
            float* dp = isx ? dst_x + (size_t)row * D : dst_c + (size_t)(row - MX) * D;
            s = 0.f;
#pragma unroll
            for (int j = 0; j < 4; ++j) { const int c = (lane + 64 * j) * 4; x[j] = x[j] * rstd * *(const f32x4*)(g + c) + *(const f32x4*)(bta + c);
                if (!(stats && isx)) *(f32x4*)(dp + c) = (cg && !isx) ? x[j] * ALPHA + *(const f32x4*)(cg + c) * *(const f32x4*)(cb + c) : x[j];
                s += (x[j][0] + x[j][1]) + (x[j][2] + x[j][3]); }
            if (H) {
                mean = wave_sum(s) * (1.f / D); s2 = 0.f;
#pragma unroll
                for (int j = 0; j < 4; ++j) { x[j] = x[j] - mean; s2 += (x[j][0] * x[j][0] + x[j][1] * x[j][1]) + (x[j][2] * x[j][2] + x[j][3] * x[j][3]); }
                rstd = rsqrtf(wave_sum(s2) * (1.f / D) + LN_EPS);
            }
        }
        if (H) {
            bf16* hp = H + (size_t)row * D;
#pragma unroll
            for (int j = 0; j < 4; ++j) { const int c = (lane + 64 * j) * 4;
                const f32x4 sc = *(const f32x4*)(mod_sc + v * 6144 + c), sh = *(const f32x4*)(mod_sh + v * 6144 + c);
                const f32x4 h = x[j] * rstd * (sc + 1.f) + sh;
                *(u32x2*)(hp + c) = (u32x2){pk_bf16(h[0], h[1]), pk_bf16(h[2], h[3])}; }
        }
    }
}

namespace att {
constexpr int OP = 132;
#define MFMA32(a, b, c) __builtin_amdgcn_mfma_f32_32x32x16_bf16((a), (b), (c), 0, 0, 0)
DI int crow(int i, int h) { return (i & 3) + 8 * (i >> 2) + 4 * h; }

template <int VAR = 0>
DI void attn_unit(unsigned char* lds, const bf16* Q, const bf16* Kb, const bf16* Vt, bf16* Y, int b, int hh, int qrow0, int nkeys, float lam, const float* subg,
                  int tid, int wave, int lane, int yrow0 = -1) {
    if (yrow0 < 0) yrow0 = qrow0;
    const int map = wave >> 2, qsub = wave & 3, r = lane & 31, h = lane >> 5;
    const unsigned char* kvbase = (const unsigned char*)(Kb + (size_t)(b * 6 + hh) * 132 * 16384);
    (void)Vt;
    constexpr int TILE_B = 32768;
    auto issue = [&](int t) __attribute__((always_inline)) {
        const unsigned char* src = kvbase + (size_t)t * TILE_B + wave * 1024 + lane * 16;
        LAS unsigned char* dst = (LAS unsigned char*)lds + (t & 3) * TILE_B + wave * 1024;
#pragma unroll
        for (int i = 0; i < 4; ++i) __builtin_amdgcn_global_load_lds((const unsigned*)(src + i * 8192), (LAS unsigned*)(dst + i * 8192), 16, 0, 0);
    };
    int offs[4];
#pragma unroll
    for (int s = 0; s < 4; ++s) offs[s] = r * 128 + ((((2 * s + h) ^ ((r >> 1) & 7))) << 4);
    bf16x8 qf[4];
    { const bf16* qp = Q + (size_t)(qrow0 + qsub * 32 + r) * 768 + hh * 128 + map * 64 + 8 * h;
#pragma unroll
      for (int s = 0; s < 4; ++s) qf[s] = *(const bf16x8*)(qp + 16 * s); }
    f32x16 O[4];
#pragma unroll
    for (int e = 0; e < 4; ++e)
#pragma unroll
        for (int i = 0; i < 16; ++i) O[e][i] = 0.f;
    float mrun = -INFINITY, lrun = 0.f;
    const int nt = nkeys >> 6;
#define ATT_BAR() do { __builtin_amdgcn_sched_barrier(0); asm volatile("s_waitcnt lgkmcnt(0)\n\ts_barrier" ::: "memory"); __builtin_amdgcn_sched_barrier(0); } while (0)
#define ATT_VMWAIT(younger_exists) do { if (younger_exists) asm volatile("s_waitcnt vmcnt(4)" ::: "memory"); else asm volatile("s_waitcnt vmcnt(0)" ::: "memory"); } while (0)
#define ATT_QK(slot_t) do { const unsigned char* kt_ = lds + ((slot_t) & 3) * TILE_B + map * 8192; bf16x8 kf0[4], kf1[4]; \
        _Pragma("unroll") for (int s = 0; s < 4; ++s) { kf0[s] = *(const bf16x8*)(kt_ + offs[s]); kf1[s] = *(const bf16x8*)(kt_ + 4096 + offs[s]); } \
        __builtin_amdgcn_sched_barrier(0); \
        _Pragma("unroll") for (int i = 0; i < 16; ++i) { x0[i] = 0.f; x1[i] = 0.f; } \
        _Pragma("unroll") for (int s = 0; s < 4; ++s) { x0 = MFMA32(kf0[s], qf[s], x0); x1 = MFMA32(kf1[s], qf[s], x1); } } while (0)
#define ATT_PINX() do { \
        asm volatile("" : "+v"(x0[0]), "+v"(x0[1]), "+v"(x0[2]), "+v"(x0[3]), "+v"(x0[4]), "+v"(x0[5]), "+v"(x0[6]), "+v"(x0[7]), "+v"(x0[8]), "+v"(x0[9]), "+v"(x0[10]), "+v"(x0[11]), "+v"(x0[12]), "+v"(x0[13]), "+v"(x0[14]), "+v"(x0[15])); \
        asm volatile("" : "+v"(x1[0]), "+v"(x1[1]), "+v"(x1[2]), "+v"(x1[3]), "+v"(x1[4]), "+v"(x1[5]), "+v"(x1[6]), "+v"(x1[7]), "+v"(x1[8]), "+v"(x1[9]), "+v"(x1[10]), "+v"(x1[11]), "+v"(x1[12]), "+v"(x1[13]), "+v"(x1[14]), "+v"(x1[15])); } while (0)
    f32x16 x0, x1;
    asm volatile("s_waitcnt vmcnt(0)" ::: "memory");
    issue(0); issue(1); issue(2);
    asm volatile("s_waitcnt vmcnt(4)" ::: "memory");
    __syncthreads();
    ATT_QK(0);
    ATT_PINX();
    if (map == 1) ATT_BAR();
#pragma unroll 1
    for (int t = 0; t < nt; ++t) {
        if (VAR != 3 && map == 1 && t + 3 < nt) issue(t + 3);
        float tm = x0[0];
#pragma unroll
        for (int i = 1; i < 16; ++i) tm = fmaxf(tm, x0[i]);
#pragma unroll
        for (int i = 0; i < 16; ++i) tm = fmaxf(tm, x1[i]);
        tm = fmaxf(tm, __shfl_xor(tm, 32));
        const float mnew = fmaxf(mrun, tm);
        if (__ballot(mnew > mrun + 8.f) != 0ull) {
            const float al = __builtin_amdgcn_exp2f(mrun - mnew);
            lrun *= al;
#pragma unroll
            for (int e = 0; e < 4; ++e)
#pragma unroll
                for (int i = 0; i < 16; ++i) O[e][i] *= al;
            mrun = mnew;
        }
        float ps0 = 0.f, ps1 = 0.f;
#pragma unroll
        for (int i = 0; i < 16; ++i) { if (VAR == 1) { x0[i] = x0[i] - mrun; x1[i] = x1[i] - mrun; } else { x0[i] = __builtin_amdgcn_exp2f(x0[i] - mrun); x1[i] = __builtin_amdgcn_exp2f(x1[i] - mrun); } ps0 += x0[i]; ps1 += x1[i]; }
        lrun += ps0 + ps1;
        u32x4 pw[4];
#pragma unroll
        for (int st = 0; st < 2; ++st) {
            const int o = 8 * st;
            pw[st].x = pk_bf16(x0[o], x0[o + 1]); pw[st].y = pk_bf16(x0[o + 2], x0[o + 3]); pw[st].z = pk_bf16(x0[o + 4], x0[o + 5]); pw[st].w = pk_bf16(x0[o + 6], x0[o + 7]);
            pw[2 + st].x = pk_bf16(x1[o], x1[o + 1]); pw[2 + st].y = pk_bf16(x1[o + 2], x1[o + 3]); pw[2 + st].z = pk_bf16(x1[o + 4], x1[o + 5]); pw[2 + st].w = pk_bf16(x1[o + 6], x1[o + 7]);
        }
        asm volatile("" : "+v"(pw[0].x), "+v"(pw[0].y), "+v"(pw[0].z), "+v"(pw[0].w), "+v"(pw[1].x), "+v"(pw[1].y), "+v"(pw[1].z), "+v"(pw[1].w),
                          "+v"(pw[2].x), "+v"(pw[2].y), "+v"(pw[2].z), "+v"(pw[2].w), "+v"(pw[3].x), "+v"(pw[3].y), "+v"(pw[3].z), "+v"(pw[3].w), "+v"(lrun));
        if (map == 0) ATT_VMWAIT(t + 2 < nt);
        ATT_BAR();
        if (VAR != 3 && map == 0 && t + 3 < nt) issue(t + 3);
        {
            const unsigned char* vt = lds + (t & 3) * TILE_B + 16384;
#define ATT_VLD(dst, st) do { _Pragma("unroll") for (int eb = 0; eb < 4; ++eb) dst[eb] = *(const bf16x8*)(vt + eb * 4096 + offs[st]); } while (0)
#define ATT_PV(src, st) do { const bf16x8 pf = __builtin_bit_cast(bf16x8, pw[st]); _Pragma("unroll") for (int eb = 0; eb < 4; ++eb) { if (VAR == 2) { O[eb][0] += (float)src[eb][0] * (float)pf[0]; } else O[eb] = MFMA32(src[eb], pf, O[eb]); } } while (0)
            bf16x8 va[4], vb[4];
            ATT_VLD(va, 0); ATT_VLD(vb, 1);
            __builtin_amdgcn_sched_barrier(0);
            ATT_PV(va, 0);
            __builtin_amdgcn_sched_barrier(0);
            ATT_VLD(va, 2);
            __builtin_amdgcn_sched_barrier(0);
            ATT_PV(vb, 1);
            __builtin_amdgcn_sched_barrier(0);
            ATT_VLD(vb, 3);
            __builtin_amdgcn_sched_barrier(0);
            ATT_PV(va, 2);
            ATT_PV(vb, 3);
        }
        __builtin_amdgcn_sched_barrier(0);
        if (t + 1 < nt) { ATT_QK(t + 1); }
        ATT_PINX();
        if (map == 1) ATT_VMWAIT(t + 3 < nt);
        ATT_BAR();
    }
    if (map == 0) ATT_BAR();
    asm volatile("s_waitcnt vmcnt(0)" ::: "memory");
    __syncthreads();
    const float lt = lrun + __shfl_xor(lrun, 32), inv = 1.f / lt;
    float* ob = (float*)lds;
    if (map == 1) {
#pragma unroll
        for (int eb = 0; eb < 4; ++eb)
#pragma unroll
            for (int i4 = 0; i4 < 4; ++i4) {
                f32x4 v = {O[eb][4 * i4] * inv, O[eb][4 * i4 + 1] * inv, O[eb][4 * i4 + 2] * inv, O[eb][4 * i4 + 3] * inv};
                *(f32x4*)(ob + (qsub * 32 + r) * OP + 32 * eb + 8 * i4 + 4 * h) = v;
            }
    }
    __syncthreads();
    if (map == 0) {
        float ss = 0.f;
#pragma unroll
        for (int eb = 0; eb < 4; ++eb)
#pragma unroll
            for (int i4 = 0; i4 < 4; ++i4) {
                const f32x4 o1 = *(const f32x4*)(ob + (qsub * 32 + r) * OP + 32 * eb + 8 * i4 + 4 * h);
#pragma unroll
                for (int j = 0; j < 4; ++j) { const float d = O[eb][4 * i4 + j] * inv - lam * o1[j]; O[eb][4 * i4 + j] = d; ss += d * d; }
            }
        ss += __shfl_xor(ss, 32);
        const float rn = rsqrtf(ss * (1.f / 128.f) + LN_EPS) * 0.8f;
        bf16* yp = Y + (size_t)(yrow0 + qsub * 32 + r) * D + 256 + hh * 128;
#pragma unroll
        for (int eb = 0; eb < 4; ++eb)
#pragma unroll
            for (int i4 = 0; i4 < 4; ++i4) {
                const int e = 32 * eb + 8 * i4 + 4 * h;
                const f32x4 g = *(const f32x4*)(subg + e);
                *(u32x2*)(yp + e) = (u32x2){pk_bf16(O[eb][4 * i4] * rn * g[0], O[eb][4 * i4 + 1] * rn * g[1]), pk_bf16(O[eb][4 * i4 + 2] * rn * g[2], O[eb][4 * i4 + 3] * rn * g[3])};
            }
    }
    __syncthreads();
}
}

DI void fft_lds_cols64(float2* X, const float2* TW, int logN, int tid) {
    const int N = 1 << logN, nb = (N >> 1) * 64;
    for (int s = 1; s <= logN; ++s) {
        const int half = 1 << (s - 1), tsh = 7 - s;
#pragma unroll 4
        for (int t = tid; t < nb; t += NTHR) {
            const int c = t & 63, bf = t >> 6, j = bf & (half - 1), grp = bf >> (s - 1);
            const int i0 = (grp << s) + j, i1 = i0 + half;
            const float2 w = TW[j << tsh];
            const float2 a = X[i0 * 64 + c], bq = X[i1 * 64 + c];
            const float tr = w.x * bq.x - w.y * bq.y, ti = w.x * bq.y + w.y * bq.x;
            X[i0 * 64 + c] = make_float2(a.x + tr, a.y + ti); X[i1 * 64 + c] = make_float2(a.x - tr, a.y - ti);
        }
        __syncthreads();
    }
}
DI int bitrev(int v, int bits) { return (int)(__brev((unsigned)v) >> (32 - bits)); }
constexpr int FFT_TW_OFF = 65536, FFT_TW2_OFF = 65536 + 512;

template <int logN1>
DI void fft_step1(unsigned char* lds, const float* FG, unsigned* T, int bg, int g, int rowbase, int n2, int tid) {
    float2* X = (float2*)lds; float2* TW = (float2*)(lds + FFT_TW_OFF); float2* TW2 = (float2*)(lds + FFT_TW2_OFF); constexpr int N1 = 1 << logN1;
    if (tid < 64) { float sn, cs; sincospif(-(float)tid * (1.f / 64.f), &sn, &cs); TW[tid] = make_float2(cs, sn); }
    else if (tid < 64 + N1) { const int k1 = tid - 64; float sn, cs; sincospif(-2.f * (float)(n2 * k1) / (float)(64 * N1), &sn, &cs); TW2[k1] = make_float2(cs, sn); }
    {
        constexpr int NIT = (N1 * 64 + NTHR - 1) / NTHR;
        float vr[NIT], vi[NIT];
#pragma unroll
        for (int i = 0; i < NIT; ++i) { const int t = tid + i * NTHR; if (t < N1 * 64) { const int c = t & 63, n1 = t >> 6; const float* p = FG + (size_t)(rowbase + 64 * n1 + n2) * 512 + g * 128 + c; vr[i] = p[0]; vi[i] = p[64]; } }
#pragma unroll
        for (int i = 0; i < NIT; ++i) { const int t = tid + i * NTHR; if (t < N1 * 64) { const int c = t & 63, n1 = t >> 6; X[bitrev(n1, logN1) * 64 + c] = make_float2(vr[i], vi[i]); } }
    }
    __syncthreads();
    fft_lds_cols64(X, TW, logN1, tid);
    for (int t = tid; t < N1 * 64; t += NTHR) { const int c = t & 63, k1 = t >> 6; const float2 w = TW2[k1];
        const float2 a = X[k1 * 64 + c];
        T[((size_t)(bg * N1 + k1) * 64 + n2) * 64 + c] = pk_bf16(a.x * w.x - a.y * w.y, a.x * w.y + a.y * w.x); }
    __syncthreads();
}
DI void fft_step3(unsigned char* lds, const unsigned* T, bf16* Y, int bg, int g, int rowbase, int k1, int N1, float scale, int tid) {
    float2* X = (float2*)lds; float2* TW = (float2*)(lds + FFT_TW_OFF);
    if (tid < 64) { float sn, cs; sincospif(-(float)tid * (1.f / 64.f), &sn, &cs); TW[tid] = make_float2(cs, sn); }
    {
        float2 v[8];
#pragma unroll
        for (int i = 0; i < 8; ++i) { const int t = tid + i * NTHR, c = t & 63, n2 = t >> 6; const unsigned w = T[((size_t)(bg * N1 + k1) * 64 + n2) * 64 + c];
            v[i] = make_float2(__builtin_bit_cast(float, w << 16), __builtin_bit_cast(float, w & 0xffff0000u)); }
#pragma unroll
        for (int i = 0; i < 8; ++i) { const int t = tid + i * NTHR, c = t & 63, n2 = t >> 6; X[bitrev(n2, 6) * 64 + c] = v[i]; }
    }
    __syncthreads();
    fft_lds_cols64(X, TW, 6, tid);
    for (int t = tid; t < 64 * 64; t += NTHR) { const int c = t & 63, k2 = t >> 6; Y[(size_t)(rowbase + k1 + N1 * k2) * D + g * 64 + c] = bf16_1(X[k2 * 64 + c].x * scale); }
    __syncthreads();
}

struct S5Lane { float ar, ai; float br[16], bi[16]; };
DI void s5_lane_params(S5Lane& P, const float* lam_re, const float* lam_im, const float* log_dt, const float* b_re, const float* b_im, int r, int g, int p) {
    const int gi = r * 32 + g; const float lr = lam_re[gi * 64 + p], li = lam_im[gi * 64 + p], dt = expf(log_dt[gi]);
    const float mag = expf(lr * dt); float sn, cs; sincosf(li * dt, &sn, &cs);
    P.ar = mag * cs; P.ai = mag * sn;
    const float nr = P.ar - 1.f, ni = P.ai, den = 1.f / (lr * lr + li * li);
    const float fr = (nr * lr + ni * li) * den, fi = (ni * lr - nr * li) * den;
#pragma unroll
    for (int i = 0; i < 16; ++i) { const float xr = b_re[(size_t)(gi * 64 + p) * 16 + i], xi = b_im[(size_t)(gi * 64 + p) * 16 + i]; P.br[i] = fr * xr - fi * xi; P.bi[i] = fr * xi + fi * xr; }
}
DI int s5_chunk_row(int b, int c) { return c < 2 ? MX + b * 256 + c * 128 : b * SEQ + (c - 2) * 128; }
DI void s5_stage_u(float* ul, const float* S, int row0, int g, int lane) {
#pragma unroll
    for (int it = 0; it < 8; ++it) { const int t = it * 16 + (lane >> 2), q = lane & 3; *(f32x4*)(ul + t * 16 + q * 4) = *(const f32x4*)(S + (size_t)(row0 + t) * 512 + g * 16 + q * 4); }
    LDS_WAIT(); asm volatile("" ::: "memory");
}
DI void s5_step(const S5Lane& P, const float* ut, float& hr, float& hi) {
    float br = 0.f, bi = 0.f;
#pragma unroll
    for (int q = 0; q < 4; ++q) { const f32x4 u = *(const f32x4*)(ut + 4 * q);
#pragma unroll
        for (int j = 0; j < 4; ++j) { br += P.br[4 * q + j] * u[j]; bi += P.bi[4 * q + j] * u[j]; } }
    const float nr = P.ar * hr - P.ai * hi + br, ni = P.ar * hi + P.ai * hr + bi; hr = nr; hi = ni;
}
DI void s5_pass_a(float* wl, const float* S, float2* E, const float* const* in, int item, int lane) {
    const int c = item % 66, r = (item / 66) & 1, g = (item / 132) & 31, b = item / (132 * 32);
    S5Lane P; s5_lane_params(P, in[23], in[24], in[25], in[26], in[27], r, g, lane);
    s5_stage_u(wl, S, s5_chunk_row(b, c), g, lane);
    float hr = 0.f, hi = 0.f;
    for (int t = 0; t < 128; ++t) s5_step(P, wl + (r ? 127 - t : t) * 16, hr, hi);
    E[(size_t)(((b * 32 + g) * 2 + r) * 66 + c) * 64 + lane] = make_float2(hr, hi);
    LDS_WAIT(); asm volatile("" ::: "memory");
}
DI float gelu_tanh(float x) { const float z = 0.7978845608028654f * (x + 0.044715f * x * x * x); return x - x / (1.f + __expf(2.f * z)); }
DI void s5_pass_b(float* wl, const float* S, const float2* E, float* GF, bf16* GA, const float* const* in, int item, int lane) {
    typedef float f32x4v __attribute__((ext_vector_type(4)));
    const int c = item & 63, g = (item >> 6) & 31, b = item >> 11;
    float* ul = wl;
    unsigned char* hs = (unsigned char*)(wl + 2048);
    const int row0 = b * SEQ + c * 128, fr = lane & 15, fq = lane >> 4;
    s5_stage_u(ul, S, row0, g, lane);
    const float dsk = in[30][g * 16 + fr];
    f32x4v yf[8];
#pragma unroll 1
    for (int r = 0; r < 2; ++r) {
        S5Lane P; s5_lane_params(P, in[23], in[24], in[25], in[26], in[27], r, g, lane);
        bf16x8 cf[4];
#pragma unroll
        for (int ks = 0; ks < 4; ++ks) {
            const size_t o = (size_t)((r * 32 + g) * 16 + fr) * 64 + 16 * ks + 4 * fq;
            const f32x4v cr = *(const f32x4v*)(in[28] + o), ci = *(const f32x4v*)(in[29] + o);
            u32x4 w; w.x = pk_bf16(cr[0], -ci[0]); w.y = pk_bf16(cr[1], -ci[1]); w.z = pk_bf16(cr[2], -ci[2]); w.w = pk_bf16(cr[3], -ci[3]);
            cf[ks] = __builtin_bit_cast(bf16x8, w);
        }
        float pr = P.ar, pi = P.ai;
#pragma unroll
        for (int k = 0; k < 7; ++k) { const float nr = pr * pr - pi * pi, ni = 2.f * pr * pi; pr = nr; pi = ni; }
        const float2* Eb = E + (size_t)(((b * 32 + g) * 2 + r) * 66) * 64 + lane;
        float hr = 0.f, hi = 0.f;
        {
            const int n = r == 0 ? c + 2 : 65 - c;
#pragma unroll 1
            for (int k0 = 0; k0 < n; k0 += 8) {
                float2 e[8];
#pragma unroll
                for (int j = 0; j < 8; ++j) { const int k = k0 + j, q = r == 0 ? k : (k == 0 ? 1 : (k == 1 ? 0 : 67 - k)); e[j] = (k < n) ? Eb[q * 64] : make_float2(0.f, 0.f); }
#pragma unroll
                for (int j = 0; j < 8; ++j) if (k0 + j < n) { const float nr = pr * hr - pi * hi + e[j].x, ni = pr * hi + pi * hr + e[j].y; hr = nr; hi = ni; }
            }
        }
#pragma unroll
        for (int bk = 0; bk < 8; ++bk) {
            const int blkk = r ? 7 - bk : bk;
#pragma unroll 4
            for (int sidx = 0; sidx < 16; ++sidx) {
                const int tl = r ? 15 - sidx : sidx;
                s5_step(P, ul + (16 * blkk + tl) * 16, hr, hi);
                *(unsigned*)(hs + tl * 272 + lane * 4) = pk_bf16(hr, hi);
            }
            LDS_WAIT(); asm volatile("" ::: "memory");
            f32x4v acc = {0.f, 0.f, 0.f, 0.f};
#pragma unroll
            for (int ks = 0; ks < 4; ++ks) {
                const bf16x8 a = *(const bf16x8*)(hs + fr * 272 + ks * 64 + fq * 16);
                acc = __builtin_amdgcn_mfma_f32_16x16x32_bf16(a, cf[ks], acc, 0, 0, 0);
            }
            LDS_WAIT(); asm volatile("" ::: "memory");
            if (r == 0) {
                if (bk == 0) yf[0] = acc; if (bk == 1) yf[1] = acc; if (bk == 2) yf[2] = acc; if (bk == 3) yf[3] = acc;
                if (bk == 4) yf[4] = acc; if (bk == 5) yf[5] = acc; if (bk == 6) yf[6] = acc; if (bk == 7) yf[7] = acc;
            } else {
                const f32x4v f = bk == 0 ? yf[7] : bk == 1 ? yf[6] : bk == 2 ? yf[5] : bk == 3 ? yf[4] : bk == 4 ? yf[3] : bk == 5 ? yf[2] : bk == 6 ? yf[1] : yf[0];
#pragma unroll
                for (int j = 0; j < 4; ++j) {
                    const int t = 16 * blkk + 4 * fq + j;
                    const float tot = dsk * ul[t * 16 + fr] + f[j] + acc[j], gg = gelu_tanh(tot);
                    GA[(size_t)(row0 + t) * 512 + g * 16 + fr] = bf16_1(gg);
                }
            }
        }
        LDS_WAIT(); asm volatile("" ::: "memory");
    }
}

DI void gmlp_item(unsigned char* lds, const float* U, const float* V, const float* wsp, const float* bsp, bf16* Y, int b, int n, int g, int tid, int wave, int lane) {
    typedef float f32x4v __attribute__((ext_vector_type(4)));
    unsigned char* vgT = lds;
    const int row0 = b * SEQ + n * 128, fr = lane & 15, fq = lane >> 4;
    bf16x8 wf[4];
    { const float* wp = wsp + (size_t)g * 16384 + (16 * wave + fr) * 128 + 8 * fq;
#pragma unroll
      for (int ks = 0; ks < 4; ++ks) { const f32x4v w0 = *(const f32x4v*)(wp + 32 * ks), w1 = *(const f32x4v*)(wp + 32 * ks + 4);
          u32x4 w; w.x = pk_bf16(w0[0], w0[1]); w.y = pk_bf16(w0[2], w0[3]); w.z = pk_bf16(w1[0], w1[1]); w.w = pk_bf16(w1[2], w1[3]); wf[ks] = __builtin_bit_cast(bf16x8, w); } }
    {
        float a0[16], a1[16], sm[16];
#pragma unroll
        for (int i = 0; i < 16; ++i) { const float* vp = V + (size_t)(row0 + 16 * wave + i) * 512 + g * 128; a0[i] = vp[lane]; a1[i] = vp[lane + 64]; sm[i] = a0[i] + a1[i]; }
#pragma unroll
        for (int o = 1; o < 64; o <<= 1) {
#pragma unroll
            for (int i = 0; i < 16; ++i) sm[i] += __shfl_xor(sm[i], o);
        }
#pragma unroll
        for (int i = 0; i < 16; ++i) { const float mean = sm[i] * (1.f / 128.f); a0[i] -= mean; a1[i] -= mean; sm[i] = a0[i] * a0[i] + a1[i] * a1[i]; }
#pragma unroll
        for (int o = 1; o < 64; o <<= 1) {
#pragma unroll
            for (int i = 0; i < 16; ++i) sm[i] += __shfl_xor(sm[i], o);
        }
#pragma unroll
        for (int i = 0; i < 16; ++i) { const float rstd = rsqrtf(sm[i] * (1.f / 128.f) + LN_EPS); a0[i] *= rstd; a1[i] *= rstd; }
#pragma unroll
        for (int i2 = 0; i2 < 8; ++i2) {
            *(unsigned*)(vgT + lane * 272 + (16 * wave + 2 * i2) * 2) = pk_bf16(a0[2 * i2], a0[2 * i2 + 1]);
            *(unsigned*)(vgT + (lane + 64) * 272 + (16 * wave + 2 * i2) * 2) = pk_bf16(a1[2 * i2], a1[2 * i2 + 1]);
        }
    }
    __syncthreads();
    f32x4v acc[8];
#pragma unroll
    for (int mb = 0; mb < 8; ++mb) {
        acc[mb] = (f32x4v){0.f, 0.f, 0.f, 0.f};
#pragma unroll
        for (int ks = 0; ks < 4; ++ks) {
            const bf16x8 a = *(const bf16x8*)(vgT + (16 * mb + fr) * 272 + 64 * ks + 16 * fq);
            acc[mb] = __builtin_amdgcn_mfma_f32_16x16x32_bf16(a, wf[ks], acc[mb], 0, 0, 0);
        }
    }
    const int p = 16 * wave + fr; const float bb = bsp[g * 128 + p];
#pragma unroll
    for (int mb = 0; mb < 8; ++mb) {
        const int c = 16 * mb + 4 * fq;
        const f32x4v u = *(const f32x4v*)(U + (size_t)(row0 + p) * 512 + g * 128 + c);
        *(u32x2*)(Y + (size_t)(row0 + p) * D + 512 + g * 128 + c) = (u32x2){pk_bf16(u[0] * (acc[mb][0] + bb), u[1] * (acc[mb][1] + bb)), pk_bf16(u[2] * (acc[mb][2] + bb), u[3] * (acc[mb][3] + bb))};
    }
    __syncthreads();
}

constexpr int N_PHASES = 20;
__global__ void __launch_bounds__(NTHR, 2) mega_fwd(Args args) {
    extern __shared__ __attribute__((aligned(16))) unsigned char lds[];
    cg::grid_group grid = cg::this_grid();
    const int tid = threadIdx.x, lane = tid & 63, wave = __builtin_amdgcn_readfirstlane(tid >> 6);
    const int G = gridDim.x, blk = blockIdx.x, gw = blk * NWAVES + wave, ngw = G * NWAVES;
    const int lo = args.ph_lo, hi = args.ph_hi;
    unsigned char* ws = args.ws;
    const float* const* in = args.in;
    float* XO = args.out;
    float* XC = (float*)(ws + WS_XC);
    float* MODP = (float*)(ws + WS_MODP); float* MOD = (float*)(ws + WS_MOD);
    float* ROPEC = (float*)(ws + WS_ROPE); float* ROPES = ROPEC + 2048;
    bf16* WIN0 = (bf16*)(ws + WS_WIN0); bf16* WOUT = (bf16*)(ws + WS_WOUT); bf16* W1 = (bf16*)(ws + WS_W1); bf16* W2 = (bf16*)(ws + WS_W2);
    bf16* WCD = (bf16*)(ws + WS_WCD); bf16* WGLU = (bf16*)(ws + WS_WGLU);
    bf16* H = (bf16*)(ws + WS_H); bf16* Y = (bf16*)(ws + WS_Y); bf16* ACT = (bf16*)(ws + WS_BIG);
    bf16* Qb = (bf16*)(ws + WS_Q); bf16* Kb = (bf16*)(ws + WS_K); bf16* Vt = (bf16*)(ws + WS_VT); float* FG = (float*)(ws + WS_FG);
    unsigned* TF = (unsigned*)(ws + WS_H);
    unsigned* TFC = TF + (size_t)8 * 128 * 4096;
    float* Sb = (float*)(ws + WS_S); float* Ub = (float*)(ws + WS_U); float* Vb = (float*)(ws + WS_V); bf16* GA = (bf16*)(ws + WS_GA); float* GF = (float*)(ws + WS_H);
    float2* Eb = (float2*)(ws + WS_E);
    PG8_LAS unsigned char* ldsp = (PG8_LAS unsigned char*)lds;
    volatile LAS unsigned* xst = (volatile LAS unsigned*)((LAS unsigned char*)lds + (LDS_BYTES - 64));
    if (tid < 2) xst[tid] = 0u;
    __syncthreads();
    XcdBarrier xbar; xbar.bar = (unsigned*)(ws + WS_BAR); xbar.x = 0; xbar.st = xst;
    if (hi - lo > 1) xbar = xcd_barrier_post((unsigned*)(ws + WS_BAR), xst);
#ifndef PHMASK
#define PHMASK 0xFFFFFu
#endif
#define IN(k) (((PHMASK >> ((k) > 14 ? (k) - 9 : (k))) & 1u) && lo <= (k) && (k) < hi)
#define SEAM(k) do { if ((k) + 1 < hi) { for (int rep_ = 0; rep_ < REP_SYNC; ++rep_) { xcd_barrier(xbar); } } } while (0)

    if (lo < 0) grid.sync();
    if (IN(0)) {
        for (int rep = 0; rep < REP_P01; ++rep) {
        for (int it = gw; it < 2 * 16 * 96; it += ngw) {
            const int cb = it % 96, ks = (it / 96) & 15, l = it / (96 * 16), n = cb * 64 + lane;
            const float* w = in[4] + (size_t)l * 1024 * 6144;
            float a0 = 0.f, a1 = 0.f, a2 = 0.f;
            float s0, s1, s2; { const float c0 = in[1][ks * 64 + lane], c1 = in[1][1024 + ks * 64 + lane], c2 = in[3][ks * 64 + lane];
                s0 = c0 / (1.f + __expf(-c0)); s1 = c1 / (1.f + __expf(-c1)); s2 = c2 / (1.f + __expf(-c2)); }
#pragma unroll 1
            for (int k0 = 0; k0 < 64; k0 += 16) {
                float wv[16];
#pragma unroll
                for (int kk = 0; kk < 16; ++kk) wv[kk] = w[(size_t)(ks * 64 + k0 + kk) * 6144 + n];
#pragma unroll
                for (int kk = 0; kk < 16; ++kk) { const int sl = k0 + kk;
                    a0 += __builtin_bit_cast(float, __builtin_amdgcn_readlane(__builtin_bit_cast(int, s0), sl)) * wv[kk]; a1 += __builtin_bit_cast(float, __builtin_amdgcn_readlane(__builtin_bit_cast(int, s1), sl)) * wv[kk];
                    a2 += __builtin_bit_cast(float, __builtin_amdgcn_readlane(__builtin_bit_cast(int, s2), sl)) * wv[kk]; }
            }
            float* pp = MODP + (size_t)((l * 16 + ks) * 3) * 6144 + n; pp[0] = a0; pp[6144] = a1; pp[2 * 6144] = a2;
        }
        for (int i = gw * 64 + lane; i < 2048; i += ngw * 64) { const int pos = i >> 4, f = i & 15; const float inv = powf(10000.f, -(float)f / 16.f), ang = (float)pos * inv;
            float sn, cs; sincosf(ang, &sn, &cs); ROPEC[i] = cs; ROPES[i] = sn; }
        {
            float* twt = (float*)lds + 8 * 2304;
            if (tid < 64) { twt[tid] = cospif((float)tid * (1.f / 32.f)); twt[64 + tid] = -sinpif((float)tid * (1.f / 32.f)); }
            __syncthreads();
            for (int it = gw; it < 512 * 16; it += ngw) {
                const int n = it >> 4, k = (it & 15) * 64 + lane, g = n >> 7, j = n & 127, jj = j & 63;
                const float* w = in[16] + (size_t)k * 2560 + g * 64; const float* tb = twt + (j < 64 ? 0 : 64); float a = 0.f;
#pragma unroll 4
                for (int c4 = 0; c4 < 64; c4 += 4) { const f32x4 wv = *(const f32x4*)(w + c4);
#pragma unroll
                    for (int e = 0; e < 4; ++e) a += wv[e] * tb[((c4 + e) * jj) & 63]; }
                WIN0[(size_t)n * 1024 + k] = bf16_1(a);
            }
            __syncthreads();
        }
        }
        SEAM(0);
    }
    if (IN(1)) {
        for (int rep = 0; rep < REP_P01; ++rep) {
        for (int i = gw * 64 + lane; i < 2 * 3 * 6144; i += ngw * 64) { const int n = i % 6144, v = (i / 6144) % 3, l = i / (3 * 6144);
            float a = in[5][l * 6144 + n];
            for (int ks = 0; ks < 16; ++ks) a += MODP[(size_t)((l * 16 + ks) * 3 + v) * 6144 + n];
            MOD[i] = a; }
        float* scr = (float*)lds + wave * 2304;
        constexpr int I_IN = 16 * 72, I_O = 16 * 32, I_1 = 16 * 128, I_2 = 64 * 32, I_CD = 16 * 48, I_GL = 8 * 16;
        constexpr int NIT = I_IN + 2 * I_O + 2 * I_1 + 2 * I_2 + I_CD + I_GL;
        for (int it = gw; it < NIT; it += ngw) {
            int r = it;
            if (r < I_IN) { transpose_item(in[16], 1024, 2560, WIN0, 256, scr, r / 72, 8 + r % 72, lane); continue; } r -= I_IN;
            if (r < 2 * I_O) { const int l = r / I_O; r %= I_O; transpose_item(in[6] + (size_t)l * D * D, D, D, WOUT + (size_t)l * D * D, 0, scr, r / 32, r % 32, lane); continue; } r -= 2 * I_O;
            if (r < 2 * I_1) { const int l = r / I_1; r %= I_1; transpose_item(in[10] + (size_t)l * D * FF, D, FF, W1 + (size_t)l * D * FF, 0, scr, r / 128, r % 128, lane); continue; } r -= 2 * I_1;
            if (r < 2 * I_2) { const int l = r / I_2; r %= I_2; transpose_item(in[12] + (size_t)l * D * FF, FF, D, W2 + (size_t)l * D * FF, 0, scr, r / 32, r % 32, lane); continue; } r -= 2 * I_2;
            if (r < I_CD) { transpose_item(in[22], 1024, 1536, WCD, 0, scr, r / 48, r % 48, lane); continue; } r -= I_CD;
            transpose_item(in[31], 512, 512, WGLU, 0, scr, r / 16, r % 16, lane);
        }
        }
        SEAM(1);
    }
    if (IN(2)) { for (int rep = 0; rep < REP_LN2; ++rep) ln_phase(in[0], in[2], nullptr, XC, MALL, nullptr, nullptr, MOD + 0 * 1024, MOD + 1 * 1024, H, gw, ngw, lane, MOD + 2 * 6144 + 2 * 1024, in[7]); SEAM(2); }
    if (IN(3)) {
        pg8::Gemm g{H, WIN0, MALL, 2816, D}; pg8::StaticOrder S; S.init(MALL, 2816, G, blk);
        pg8::EpiInL0 E{FG, Qb, Kb, Vt, ROPEC, ROPES, 0.125f * 1.4426950408889634f};
        for (int rep = 0; rep < REP_G3; ++rep)
        pg8::gemm_phase<pg8::EpiInL0, pg8::StaticOrder, true, true>(ldsp, g, S, E);
        SEAM(3);
    }
    if (IN(4)) {
        float lam;
        { const float d1 = wave_sum(in[17][lane] * in[18][lane]), d2 = wave_sum(in[19][lane] * in[20][lane]); lam = expf(d1) - expf(d2) + 0.2f; }
        const float* subg = in[21];
        const int nun = 768 + 24;
        for (int rep = 0; rep < REP_ATT; ++rep)
        for (int i = 0;; ++i) {
            int U;
            if (G == 256) { if (i < 3) U = (blk & 7) * 96 + (blk >> 3) + 32 * i; else { U = 768 + blk + (i - 3) * G; } }
            else U = blk + i * G;
            if (U >= nun) break;
            if (U < 768) { const int bh = U >> 6, qb = U & 63, b = bh / 6, hh = bh % 6; att::attn_unit<0>(lds, Qb, Kb, Vt, Y, b, hh, b * SEQ + qb * 128, NKEY, lam, subg, tid, wave, lane); }
            else { const int u2 = U - 768, b = u2 / 12, hh = (u2 / 2) % 6, qb = u2 & 1; att::attn_unit<0>(lds, Qb, Kb, Vt, Y, b, hh, MX + b * CTX + qb * 128, CTX, lam, subg, tid, wave, lane); }
        }
#if PROBE_ATT_VAR >= 0
        for (int i = 0; i < 3; ++i) {
            const int U = (G == 256) ? (blk & 7) * 96 + (blk >> 3) + 32 * i : blk + i * G; if (U >= 768) break;
            const int bh = U >> 6, qb = U & 63, b = bh / 6, hh = bh % 6;
            att::attn_unit<PROBE_ATT_VAR>(lds, Qb, Kb, Vt, (bf16*)(ws + WS_BIG + 108 * MiB), b, hh, b * SEQ + qb * 128, NKEY, lam, subg, tid, wave, lane, qb * 128);
        }
#endif
        for (int rep = 0; rep < REP_FFT; ++rep)
        for (int it = blk; it < 1024; it += G) {
            const int bg = (it >> 6) & 7, n2 = it & 63;
            if (it < 512) fft_step1<7>(lds, FG, TF, bg, bg & 3, (bg >> 2) * SEQ, n2, tid);
            else fft_step1<2>(lds, FG, TFC, bg, bg & 3, MX + (bg >> 2) * CTX, n2, tid);
        }
        SEAM(4);
    }
    if (IN(5)) {
        for (int rep = 0; rep < REP_FFT; ++rep)
        for (int it = blk; it < 1024 + 32; it += G) {
            if (it < 1024) { const int bg = it >> 7, k1 = it & 127; fft_step3(lds, TF, Y, bg, bg & 3, (bg >> 2) * SEQ, k1, 128, 0.0013810679320049757f, tid); }
            else { const int i2 = it - 1024, bg = i2 >> 2, k1 = i2 & 3; fft_step3(lds, TFC, Y, bg, bg & 3, MX + (bg >> 2) * CTX, k1, 4, 0.0078125f, tid); }
        }
        SEAM(5);
    }
    auto layer_tail = [&](auto LC) __attribute__((always_inline)) {
        constexpr int l = decltype(LC)::value;
        constexpr int pb = l == 0 ? 6 : 15;
        constexpr int M = l == 0 ? MALL : MX;
        const float* modl = MOD + (size_t)l * 3 * 6144;
        if constexpr (l == 1) {
            if (IN(11)) {
                pg8::Gemm g{H, WCD, MALL, 1536, D}; pg8::StaticOrder S; S.init(MALL, 1536, G, blk);
                pg8::EpiInL1 E{Sb, Ub, Vb};
                pg8::gemm_phase<pg8::EpiInL1, pg8::StaticOrder, true, true>(ldsp, g, S, E);
                SEAM(11);
            }
            if (IN(12)) {
                float* wl = (float*)lds + wave * 4096;
                for (int rep = 0; rep < REP_S5; ++rep)
                for (int it = gw; it < 2 * 32 * 2 * 66; it += ngw) s5_pass_a(wl, Sb, Eb, in, it, lane);
                __syncthreads();
                for (int rep = 0; rep < REP_GMLP; ++rep)
                {
                    const int gb0 = (G == 256) ? 32 : 0, gnb = G - gb0;
                    if (blk >= gb0) for (int it = blk - gb0; it < 512; it += gnb) { const int g = it & 3, n = (it >> 2) & 63, b = it >> 8; gmlp_item(lds, Ub, Vb, in[33], in[34], Y, b, n, g, tid, wave, lane); }
                }
                SEAM(12);
            }
            if (IN(13)) {
                float* wl = (float*)lds + wave * 4096;
                for (int rep = 0; rep < REP_S5; ++rep)
                for (int it = gw; it < 2 * 32 * 64; it += ngw) s5_pass_b(wl, Sb, Eb, GF, GA, in, it, lane);
                SEAM(13);
            }
            if (IN(14)) {
                pg8::Gemm g{GA, WGLU, MX, 512, 512}; pg8::StaticOrder S; S.init(MX, 512, G, blk);
                pg8::EpiGlu E{(const pg8::bf16_t*)GA, Y, in[32]};
                pg8::gemm_phase<pg8::EpiGlu, pg8::StaticOrder, true, true>(ldsp, g, S, E);
                SEAM(14);
            }
        }
        if (IN(pb)) {
            pg8::Gemm g{Y, WOUT + (size_t)l * D * D, M, D, D}; pg8::SplitOrder S; S.init(MX, D, D, G, blk, l == 0 ? 2 : 0, 8);
            pg8::EpiResGate E{l == 0 ? in[0] : XO, l == 0 ? in[2] : XC, XO, XC, modl + 2 * 1024, in[7] + l * D, ALPHA, (float*)(ws + WS_BIG), D / 8, l == 1 ? (const float*)(ws + WS_ST2) : nullptr, in[14], in[15]};
            pg8::gemm_phase<pg8::EpiResGate, pg8::SplitOrder, true, true>(ldsp, g, S, E);
            SEAM(pb);
        }
        if (IN(pb + 1)) { ln_phase(XO, XC, XO, XC, M, in[8] + l * D, in[9] + l * D, modl + 3 * 1024, modl + 4 * 1024, H, gw, ngw, lane, l == 0 ? modl + 2 * 6144 + 5 * 1024 : nullptr, in[13] + l * D, l == 0 ? (const float*)(ws + WS_BIG) : nullptr, 8, (float*)(ws + WS_ST1)); SEAM(pb + 1); }
        if (IN(pb + 2)) {
            pg8::Gemm g{H, W1 + (size_t)l * D * FF, M, FF, D}; pg8::StaticOrder S; S.init(M, FF, G, blk);
            pg8::EpiSqRelu E{ACT, FF, in[11] + l * FF};
            for (int rep = 0; rep < REP_FFN1; ++rep)
            pg8::gemm_phase<pg8::EpiSqRelu, pg8::StaticOrder, true, true>(ldsp, g, S, E);
            SEAM(pb + 2);
        }
        if (IN(pb + 3)) {
            pg8::Gemm g{ACT, W2 + (size_t)l * D * FF, M, D, FF}; pg8::SplitOrder S; S.init(MX, D, FF, G, blk, l == 0 ? 2 : 0, 16);
            pg8::EpiResGate E{XO, XC, XO, XC, modl + 5 * 1024, in[13] + l * D, ALPHA, (float*)(ws + WS_Y), FF / 16, (const float*)(ws + WS_ST1), in[8] + l * D, in[9] + l * D};
            pg8::gemm_phase<pg8::EpiResGate, pg8::SplitOrder, true, true>(ldsp, g, S, E);
            SEAM(pb + 3);
        }
        if (IN(pb + 4)) {
            if constexpr (l == 0) ln_phase(XO, XC, XO, XC, MALL, in[14], in[15], MOD + 3 * 6144 + 0 * 1024, MOD + 3 * 6144 + 1 * 1024, H, gw, ngw, lane, nullptr, nullptr, (const float*)(ws + WS_Y), 16, (float*)(ws + WS_ST2));
            else ln_phase(XO, XC, XO, XC, MX, in[14] + D, in[15] + D, nullptr, nullptr, nullptr, gw, ngw, lane);
            SEAM(pb + 4);
        }
    };
    layer_tail(std::integral_constant<int, 0>{});
    layer_tail(std::integral_constant<int, 1>{});
#undef IN
#undef SEAM
}

extern "C" void kernel_launch(void* const* d_in, const int* in_sizes, int n_in, void* d_out, int out_size, void* d_ws, size_t ws_size, hipStream_t stream) {
    static int grid = 0;
    if (grid == 0) {
        if (n_in != 35 || out_size != MX * D || ws_size < WS_END) { fprintf(stderr, "kernel_launch: unexpected problem shape (n_in %d out %d ws %zu)\n", n_in, out_size, ws_size); grid = -1; return; }
        int dev = 0, cus = 0, per_cu = 0;
        hipGetDevice(&dev); hipDeviceGetAttribute(&cus, hipDeviceAttributeMultiprocessorCount, dev);
        if (hipFuncSetAttribute((const void*)mega_fwd, hipFuncAttributeMaxDynamicSharedMemorySize, LDS_BYTES) != hipSuccess) { fprintf(stderr, "kernel_launch: hipFuncSetAttribute failed\n"); grid = -1; return; }
        if (hipOccupancyMaxActiveBlocksPerMultiprocessor(&per_cu, (const void*)mega_fwd, NTHR, LDS_BYTES) != hipSuccess || per_cu < 1) { fprintf(stderr, "kernel_launch: occupancy query says %d blocks/CU\n", per_cu); grid = -1; (void)hipGetLastError(); return; }
        grid = cus * 1;
    }
    if (grid < 0) return;
    Args a{};
    for (int i = 0; i < 35; ++i) a.in[i] = (const float*)d_in[i];
    a.out = (float*)d_out; a.ws = (unsigned char*)d_ws;
#if MK_MULTI
    for (int ph = 0; ph < N_PHASES; ++ph) { a.ph_lo = ph; a.ph_hi = ph + 1; hipLaunchKernelGGL(mega_fwd, dim3(grid), dim3(NTHR), LDS_BYTES, stream, a); }
#else
    if (hipMemsetAsync((char*)d_ws + WS_BAR, 0, XCD_BAR_WORDS * 4, stream) != hipSuccess) { fprintf(stderr, "kernel_launch: memset of the barrier words failed\n"); return; }
    a.ph_lo = 0; a.ph_hi = N_PHASES;
    void* kargs[] = {&a};
    hipError_t e = hipLaunchCooperativeKernel((const void*)mega_fwd, dim3(grid), dim3(NTHR), kargs, LDS_BYTES, stream);
    if (e != hipSuccess) fprintf(stderr, "kernel_launch: cooperative launch failed: %s (grid %d)\n", hipGetErrorString(e), grid);
#endif
}
```

```cpp
#include <hip/hip_runtime.h>
#include <hip/hip_cooperative_groups.h>
#include <cstdio>
#include <cstdint>
#include <type_traits>
namespace cg = cooperative_groups;
#ifndef MK_MULTI
#define MK_MULTI 0
#endif
#ifndef REP_ATT
#define REP_ATT 1
#endif
#ifndef REP_S5
#define REP_S5 1
#endif
#ifndef REP_G3
#define REP_G3 1
#endif
#ifndef REP_FFN1
#define REP_FFN1 1
#endif
#ifndef REP_P01
#define REP_P01 1
#endif
#ifndef REP_FFT
#define REP_FFT 1
#endif
#ifndef REP_GMLP
#define REP_GMLP 1
#endif
#ifndef REP_SYNC
#define REP_SYNC 1
#endif
#ifndef PROBE_ATT_VAR
#define PROBE_ATT_VAR -1
#endif
#ifndef REP_LN2
#define REP_LN2 1
#endif
namespace pg8 {
#define PG8_LAS __attribute__((address_space(3)))
typedef unsigned short bf16_t;
typedef short bf16x8 __attribute__((ext_vector_type(8)));
typedef float f32x4 __attribute__((ext_vector_type(4)));
typedef unsigned u32x4 __attribute__((ext_vector_type(4)));
constexpr int BM = 256, BK = 64, HALF = 128, HTB = HALF * BK * 2  , STAGE_BYTES = 8 * HTB, NXCD = 8, WGM = 4;

__host__ __device__ __forceinline__ int lds_byte(int r, int c) { const int st = (r >> 4) * 2 + (c >> 5), rr = r & 15, cc = c & 31, ob = rr * 64 + cc * 2; return st * 1024 + (ob ^ (((ob >> 9) & 1) << 5)); }
__host__ __device__ __forceinline__ void stage_rc(int b, int& R, int& C) { const int st = b / 1024, sb = b % 1024, swz = sb ^ (((sb >> 9) & 1) << 5); R = (st >> 1) * 16 + swz / 64; C = (st & 1) * 32 + (swz % 64) / 2; }
__host__ __device__ __forceinline__ int perm32(int rho) { const int n = rho >> 4, i = rho & 15; return 8 * (i >> 2) + 4 * n + (i & 3); }

struct Unit { int pm, pn; int k0 = 0, nt = 0, atomic = 0; };
struct Gemm { const bf16_t* A; const bf16_t* Bt; int M, N, K; };

struct StaticOrder {
    int nM, nN, nwg, G, c;
    __host__ __device__ void init(int M, int N, int G_, int c_) { nM = M / BM; nN = N / BM; nwg = nM * nN; G = G_; c = c_; }
    __host__ __device__ bool next(int i, Unit& u) const {
        const long L = (long)i * G + c; if (L >= nwg) return false;
        int wgid = (int)L; { const int q = nwg / NXCD, r = nwg % NXCD, xcd = wgid % NXCD, off = wgid / NXCD; wgid = (xcd < r ? xcd * (q + 1) : r * (q + 1) + (xcd - r) * q) + off; }
        const int nig = WGM * nN, gid = wgid / nig, fm = gid * WGM, gsz = (nM - fm) < WGM ? (nM - fm) : WGM;
        u.pm = fm + ((wgid % nig) % gsz); u.pn = (wgid % nig) / gsz; return true;
    }
    __device__ __forceinline__ void a_ready(const Unit&) const {}
    __device__ __forceinline__ void done(const Unit&) const {}
};

__device__ __forceinline__ unsigned cvt_pk_bf16(float lo, float hi) { unsigned r; asm volatile("v_cvt_pk_bf16_f32 %0, %1, %2" : "=v"(r) : "v"(lo), "v"(hi)); return r; }
struct SplitOrder {
    StaticOrder base; int G, c, nN, nsplit, kslice, nctx;
    __host__ __device__ void init(int Mx, int N, int K, int G_, int c_, int ctx_tiles_m, int nsplit_) { base.init(Mx, N, G_, c_); G = G_; c = c_; nN = N / BM; nsplit = nsplit_; kslice = K / nsplit_; nctx = ctx_tiles_m * nN * nsplit_; }
    __host__ __device__ bool next(int i, Unit& u) const {
        const long L = (long)i * G + c;
        if (L < base.nwg) { const bool ok = base.next(i, u); u.k0 = 0; u.nt = 0; u.atomic = 0; return ok; }
        const int j = (int)(L - base.nwg); if (j >= nctx) return false;
        const int kp = j % nsplit, t = j / nsplit;
        u.pn = t % nN; u.pm = base.nM + t / nN; u.k0 = kp * kslice; u.nt = kslice / BK; u.atomic = 1; return true;
    }
    __device__ __forceinline__ void a_ready(const Unit&) const {}
    __device__ __forceinline__ void done(const Unit&) const {}
};

constexpr int MX = 16384;
constexpr int NKEY = 8448;
typedef __bf16 bf16x2_t __attribute__((ext_vector_type(2)));
typedef float f32x2_t __attribute__((ext_vector_type(2)));
__device__ __forceinline__ unsigned pk_bf16(float lo, float hi) { f32x2_t v = {lo, hi}; bf16x2_t b = __builtin_convertvector(v, bf16x2_t); return __builtin_bit_cast(unsigned, b); }
__device__ __forceinline__ unsigned short bf16_1(float x) { return (unsigned short)(pk_bf16(x, 0.f) & 0xffffu); }
typedef unsigned u32x2 __attribute__((ext_vector_type(2)));

struct EpiInL0 {
    static constexpr bool PERM = false, AFTER_DRAIN = false;
    float* FG; bf16_t* Q; bf16_t* Kb; bf16_t* Vt; const float* ropeC; const float* ropeS; float qscale;
    __device__ __forceinline__ void operator()(const f32x4 (&acc)[2][2][4][2], const Unit& u, int wr, int wc, int fr, int fq) const {
        const int pn = u.pn;
#pragma unroll
        for (int ai = 0; ai < 2; ++ai)
#pragma unroll
            for (int m = 0; m < 4; ++m) {
                const int row = u.pm * BM + ai * HALF + wr * 64 + m * 16 + fr;
                const bool isx = row < MX;
                const int b = isx ? (row >> 13) : ((row - MX) >> 8), n = isx ? (row & 8191) : ((row - MX) & 255);
                const int key = isx ? 256 + n : n;
#pragma unroll
                for (int bj = 0; bj < 2; ++bj) {
                    const int colb = pn * BM + bj * HALF + wc * 32;
                    f32x4 v0 = acc[ai][bj][m][0], v1 = acc[ai][bj][m][1];
                    if (pn < 2) {
                        *(f32x4*)(FG + (size_t)row * 512 + colb + 4 * fq) = v0; *(f32x4*)(FG + (size_t)row * 512 + colb + 16 + 4 * fq) = v1;
                    } else if (pn < 8) {
                        if (isx) {
                            const int pos = ((colb >> 5) & 1) ? (n & 63) : (n >> 6);
                            const f32x4 c = *(const f32x4*)(ropeC + pos * 16 + 4 * fq), s = *(const f32x4*)(ropeS + pos * 16 + 4 * fq);
                            const f32x4 o0 = v0 * c - v1 * s, o1 = v1 * c + v0 * s; v0 = o0; v1 = o1;
                        }
                        if (pn < 5) {
                            v0 = v0 * qscale; v1 = v1 * qscale;
                            bf16_t* d = Q + (size_t)row * 768 + (colb - 512) + 4 * fq;
                            *(u32x2*)d = (u32x2){pk_bf16(v0[0], v0[1]), pk_bf16(v0[2], v0[3])}; *(u32x2*)(d + 16) = (u32x2){pk_bf16(v1[0], v1[1]), pk_bf16(v1[2], v1[3])};
                        } else {
                            const int ck = colb - 1280 + 4 * fq;
                            const int kk = key & 63, dd = ck & 63;
                            bf16_t* d = Kb + ((size_t)(b * 6 + (ck >> 7)) * 132 + (key >> 6)) * 16384 + (((ck >> 6) & 1) * 64 + kk) * 64 + ((((dd >> 3) ^ ((kk >> 1) & 7)) << 3) | (dd & 7));
                            *(u32x2*)d = (u32x2){pk_bf16(v0[0], v0[1]), pk_bf16(v0[2], v0[3])};
                            bf16_t* d2 = Kb + ((size_t)(b * 6 + (ck >> 7)) * 132 + (key >> 6)) * 16384 + (((ck >> 6) & 1) * 64 + kk) * 64 + (((((dd + 16) >> 3) ^ ((kk >> 1) & 7)) << 3) | (dd & 7));
                            *(u32x2*)d2 = (u32x2){pk_bf16(v1[0], v1[1]), pk_bf16(v1[2], v1[3])};
                        }
                    } else {
                        const int e0 = colb - 2048 + 4 * fq, hh = e0 >> 7, e = e0 & 127;
                        const int kk = key & 63, pos = (kk & 48) + 8 * ((kk >> 2) & 1) + 4 * ((kk >> 3) & 1) + (kk & 3);
                        bf16_t* d = Kb + ((size_t)(b * 6 + hh) * 132 + (key >> 6)) * 16384 + 8192;
#pragma unroll
                        for (int j = 0; j < 4; ++j) {
                            const int ea = e + j, eb2 = e + 16 + j;
                            d[ea * 64 + ((((pos >> 3) ^ ((ea >> 1) & 7)) << 3) | (pos & 7))] = bf16_1(v0[j]);
                            d[eb2 * 64 + ((((pos >> 3) ^ ((eb2 >> 1) & 7)) << 3) | (pos & 7))] = bf16_1(v1[j]);
                        }
                    }
                }
            }
    }
};

struct EpiResGate {
    static constexpr bool PERM = true, AFTER_DRAIN = false;
    const float* res_x; const float* res_c; float* out_x; float* out_c; const float* gate; const float* bias; float alpha; float* part; int kslice;
    const float* stats; const float* lng; const float* lnb;
    __device__ __forceinline__ void operator()(const f32x4 (&acc)[2][2][4][2], const Unit& u, int wr, int wc, int fr, int fq) const {
#pragma unroll
        for (int ai = 0; ai < 2; ++ai)
#pragma unroll
            for (int m = 0; m < 4; ++m) {
                const int row = u.pm * BM + ai * HALF + wr * 64 + m * 16 + fr;
                const bool isx = row < MX;
                const int v = isx ? (row >> 13) : 2;
                const float* rp = isx ? res_x + (size_t)row * 1024 : res_c + (size_t)(row - MX) * 1024;
                float* op = isx ? out_x + (size_t)row * 1024 : out_c + (size_t)(row - MX) * 1024;
                const float* gp = gate + v * 6144;
                float mu = 0.f, rs = 1.f; const bool dl = stats && isx;
                if (dl) { mu = stats[2 * row]; rs = stats[2 * row + 1]; }
#pragma unroll
                for (int bj = 0; bj < 2; ++bj) {
                    const int c0 = u.pn * BM + bj * HALF + wc * 32 + 8 * fq;
#pragma unroll
                    for (int n = 0; n < 2; ++n) {
                        const int c = c0 + 4 * n;
                        const f32x4 g = *(const f32x4*)(gp + c);
                        if (u.atomic) {
                            *(f32x4*)(part + ((size_t)(u.k0 / kslice) * 512 + (row - MX)) * 1024 + c) = g * acc[ai][bj][m][n];
                        } else {
                            f32x4 r = *(const f32x4*)(rp + c); const f32x4 bb = *(const f32x4*)(bias + c);
                            if (dl) r = (r - mu) * rs * *(const f32x4*)(lng + c) + *(const f32x4*)(lnb + c);
                            *(f32x4*)(op + c) = r * alpha + g * (acc[ai][bj][m][n] + bb);
                        }
                    }
                }
            }
    }
};

struct EpiSqRelu {
    static constexpr bool PERM = true, AFTER_DRAIN = false;
    bf16_t* O; int ldc; const float* bias;
    __device__ __forceinline__ void operator()(const f32x4 (&acc)[2][2][4][2], const Unit& u, int wr, int wc, int fr, int fq) const {
#pragma unroll
        for (int ai = 0; ai < 2; ++ai)
#pragma unroll
            for (int m = 0; m < 4; ++m) {
                const int row = u.pm * BM + ai * HALF + wr * 64 + m * 16 + fr;
#pragma unroll
                for (int bj = 0; bj < 2; ++bj) {
                    const int c0 = u.pn * BM + bj * HALF + wc * 32 + 8 * fq;
                    f32x4 v0 = acc[ai][bj][m][0] + *(const f32x4*)(bias + c0), v1 = acc[ai][bj][m][1] + *(const f32x4*)(bias + c0 + 4);
#pragma unroll
                    for (int j = 0; j < 4; ++j) { const float a = fmaxf(v0[j], 0.f), c = fmaxf(v1[j], 0.f); v0[j] = a * a; v1[j] = c * c; }
                    u32x4 w; w.x = pk_bf16(v0[0], v0[1]); w.y = pk_bf16(v0[2], v0[3]); w.z = pk_bf16(v1[0], v1[1]); w.w = pk_bf16(v1[2], v1[3]);
                    *(u32x4*)(O + (size_t)row * ldc + c0) = w;
                }
            }
    }
};

struct EpiInL1 {
    static constexpr bool PERM = true, AFTER_DRAIN = false;
    float* S; float* U; float* V;
    __device__ __forceinline__ void operator()(const f32x4 (&acc)[2][2][4][2], const Unit& u, int wr, int wc, int fr, int fq) const {
        const int t = u.pn >> 1;
        float* base = S + (size_t)t * (33u << 18);
#pragma unroll
        for (int ai = 0; ai < 2; ++ai)
#pragma unroll
            for (int m = 0; m < 4; ++m) {
                const int row = u.pm * BM + ai * HALF + wr * 64 + m * 16 + fr;
                if (t != 0 && row >= MX) continue;
#pragma unroll
                for (int bj = 0; bj < 2; ++bj) {
                    const int c0 = (u.pn & 1) * BM + bj * HALF + wc * 32 + 8 * fq;
                    *(f32x4*)(base + (size_t)row * 512 + c0) = acc[ai][bj][m][0]; *(f32x4*)(base + (size_t)row * 512 + c0 + 4) = acc[ai][bj][m][1];
                }
            }
    }
};

struct EpiGlu {
    static constexpr bool PERM = true, AFTER_DRAIN = false;
    const bf16_t* GAp; bf16_t* Y; const float* bias;
    __device__ __forceinline__ void operator()(const f32x4 (&acc)[2][2][4][2], const Unit& u, int wr, int wc, int fr, int fq) const {
#pragma unroll
        for (int ai = 0; ai < 2; ++ai)
#pragma unroll
            for (int m = 0; m < 4; ++m) {
                const int row = u.pm * BM + ai * HALF + wr * 64 + m * 16 + fr;
#pragma unroll
                for (int bj = 0; bj < 2; ++bj) {
                    const int c0 = u.pn * BM + bj * HALF + wc * 32 + 8 * fq;
                    f32x4 v0 = acc[ai][bj][m][0] + *(const f32x4*)(bias + c0), v1 = acc[ai][bj][m][1] + *(const f32x4*)(bias + c0 + 4);
                    const u32x4 gw = *(const u32x4*)(GAp + (size_t)row * 512 + c0);
                    const f32x4 g0 = {__builtin_bit_cast(float, gw.x << 16), __builtin_bit_cast(float, gw.x & 0xffff0000u), __builtin_bit_cast(float, gw.y << 16), __builtin_bit_cast(float, gw.y & 0xffff0000u)};
                    const f32x4 g1 = {__builtin_bit_cast(float, gw.z << 16), __builtin_bit_cast(float, gw.z & 0xffff0000u), __builtin_bit_cast(float, gw.w << 16), __builtin_bit_cast(float, gw.w & 0xffff0000u)};
#pragma unroll
                    for (int j = 0; j < 4; ++j) { v0[j] = g0[j] * __builtin_amdgcn_rcpf(1.f + __expf(-v0[j])); v1[j] = g1[j] * __builtin_amdgcn_rcpf(1.f + __expf(-v1[j])); }
                    u32x4 w; w.x = pk_bf16(v0[0], v0[1]); w.y = pk_bf16(v0[2], v0[3]); w.z = pk_bf16(v1[0], v1[1]); w.w = pk_bf16(v1[2], v1[3]);
                    *(u32x4*)(Y + (size_t)row * 1024 + c0) = w;
                }
            }
    }
};
template <class Epi, class Sched, bool ALIGN_EPI = false, bool SP2 = false>
__device__ __forceinline__ void gemm_phase(PG8_LAS unsigned char* lds, const Gemm g, const Sched& S, const Epi& E) {
    int tid_o = threadIdx.x; asm volatile("" : "+v"(tid_o));
    const int tid = tid_o, wid = __builtin_amdgcn_readfirstlane(tid >> 6), lane = tid & 63, wr = wid >> 2, wc = wid & 3, fr = lane & 15, fq = lane >> 4;
    const int K = g.K, nt = K / BK;
    unsigned voffA[2], voffB[2];
#pragma unroll
    for (int i = 0; i < 2; ++i) { int R, C; stage_rc(tid * 16 + i * 8192, R, C); const int Rb = Epi::PERM ? ((R & ~31) + perm32(R & 31)) : R;
        voffA[i] = (unsigned)(R * K + C) * 2u; voffB[i] = (unsigned)(Rb * K + C) * 2u; }
    const size_t kstep = (size_t)(BK * 2);
    const size_t hstep = (size_t)HALF * K * 2;
    const size_t tstep = 2 * hstep;
    const unsigned ldsw = (unsigned)wid * 1024u;
    const int aoff = lds_byte(wr * 64 + fr, fq * 8), boff = lds_byte(wc * 32 + fr, fq * 8);
#define PG8_SA(b, h) (((b) * 2 + (h)) * HTB)
#define PG8_SB(b, h) ((4 + (b) * 2 + (h)) * HTB)
#define PG8_STAGE(bufoff, gbase, voff) do { _Pragma("unroll") for (int _i = 0; _i < 2; ++_i) \
        __builtin_amdgcn_global_load_lds((const unsigned*)((const char*)(gbase) + (voff)[_i]), (PG8_LAS unsigned*)(lds + (bufoff) + ldsw + _i * 8192), 16, 0, 0); } while (0)
#define PG8_LDA(dst, b, h) do { _Pragma("unroll") for (int m = 0; m < 4; ++m) _Pragma("unroll") for (int k = 0; k < 2; ++k) dst[m][k] = *(const PG8_LAS bf16x8*)(lds + PG8_SA(b, h) + aoff + m * 2048 + k * 1024); } while (0)
#define PG8_LDB(dst, b, h) do { _Pragma("unroll") for (int n = 0; n < 2; ++n) _Pragma("unroll") for (int k = 0; k < 2; ++k) dst[n][k] = *(const PG8_LAS bf16x8*)(lds + PG8_SB(b, h) + boff + n * 2048 + k * 1024); } while (0)
#define PG8_MMA(ai, bj, At, Bt) do { __builtin_amdgcn_s_setprio(1); _Pragma("unroll") for (int m = 0; m < 4; ++m) _Pragma("unroll") for (int n = 0; n < 2; ++n) _Pragma("unroll") for (int k = 0; k < 2; ++k) \
        acc[ai][bj][m][n] = __builtin_amdgcn_mfma_f32_16x16x32_bf16(Bt[n][k], At[m][k], acc[ai][bj][m][n], 0, 0, 0); __builtin_amdgcn_s_setprio(0); } while (0)
#define PG8_WAIT_V(n) asm volatile("s_waitcnt vmcnt(" #n ")" ::: "memory")
#define PG8_WAIT_L(n) asm volatile("s_waitcnt lgkmcnt(" #n ")" ::: "memory")
#define PG8_BAR __builtin_amdgcn_s_barrier()
#define PG8_SCHED __builtin_amdgcn_sched_barrier(0)
    Unit cur, nxt; int ui = 0;
    if (!S.next(0, cur)) return;
    f32x4 acc[2][2][4][2];
#pragma unroll
    for (int a = 0; a < 2; ++a)
#pragma unroll
        for (int b = 0; b < 2; ++b)
#pragma unroll
            for (int m = 0; m < 4; ++m)
#pragma unroll
                for (int n = 0; n < 2; ++n) acc[a][b][m][n] = (f32x4){0.f, 0.f, 0.f, 0.f};
    bf16x8 At[4][2], B0[2][2], B1[2][2];
    const char* cA = (const char*)g.A + (size_t)cur.pm * tstep + (size_t)cur.k0 * 2; const char* cB = (const char*)g.Bt + (size_t)cur.pn * tstep + (size_t)cur.k0 * 2;
    S.a_ready(cur);
    if constexpr (SP2) {
        PG8_STAGE(PG8_SB(0, 0), cB, voffB); PG8_STAGE(PG8_SB(0, 1), cB + hstep, voffB); PG8_STAGE(PG8_SA(0, 0), cA, voffA); PG8_STAGE(PG8_SA(0, 1), cA + hstep, voffA);
        if (wr == 1) PG8_BAR;
        PG8_WAIT_V(2); PG8_BAR;
        PG8_STAGE(PG8_SB(1, 0), cB + kstep, voffB); PG8_STAGE(PG8_SA(1, 0), cA + kstep, voffA); PG8_STAGE(PG8_SB(1, 1), cB + hstep + kstep, voffB);
        PG8_WAIT_V(6); PG8_BAR;
    } else {
        PG8_STAGE(PG8_SB(0, 0), cB, voffB); PG8_STAGE(PG8_SA(0, 0), cA, voffA); PG8_STAGE(PG8_SB(0, 1), cB + hstep, voffB); PG8_STAGE(PG8_SA(0, 1), cA + hstep, voffA);
        if (wr == 1) PG8_BAR;
        PG8_WAIT_V(4); PG8_BAR;
        PG8_STAGE(PG8_SB(1, 0), cB + kstep, voffB); PG8_STAGE(PG8_SA(1, 0), cA + kstep, voffA); PG8_STAGE(PG8_SB(1, 1), cB + hstep + kstep, voffB);
        PG8_WAIT_V(6); PG8_BAR;
    }
    for (;;) {
        const bool has_next = S.next(ui + 1, nxt);
        const char* nA = has_next ? (const char*)g.A + (size_t)nxt.pm * tstep + (size_t)nxt.k0 * 2 : cA; const char* nB = has_next ? (const char*)g.Bt + (size_t)nxt.pn * tstep + (size_t)nxt.k0 * 2 : cB;
        const int ntc = cur.nt ? cur.nt : nt;
        for (int t = 0; t < ntc; t += 2) {
            const bool last = (t == ntc - 2);
            const char* a1 = cA + (size_t)(t + 1) * kstep;
            const char* a2 = last ? nA : cA + (size_t)(t + 2) * kstep; const char* b2 = last ? nB : cB + (size_t)(t + 2) * kstep;
            const char* a3 = a2 + kstep; const char* b3 = b2 + kstep;
            if (last && has_next) S.a_ready(nxt);
            if constexpr (SP2) {
            PG8_LDB(B0, 0, 0); PG8_LDB(B1, 0, 1); PG8_SCHED; PG8_LDA(At, 0, 0); PG8_STAGE(PG8_SA(1, 1), a1 + hstep, voffA);
            PG8_WAIT_V(8); PG8_WAIT_L(0); PG8_BAR; PG8_MMA(0, 0, At, B0); PG8_MMA(0, 1, At, B1); PG8_BAR; PG8_SCHED;
            PG8_LDA(At, 0, 1); PG8_STAGE(PG8_SB(0, 0), b2, voffB); PG8_STAGE(PG8_SB(0, 1), b2 + hstep, voffB); PG8_STAGE(PG8_SA(0, 0), a2, voffA);
            PG8_WAIT_V(8); PG8_WAIT_L(0); PG8_BAR; PG8_MMA(1, 0, At, B0); PG8_MMA(1, 1, At, B1); PG8_BAR; PG8_SCHED;
            PG8_LDB(B0, 1, 0); PG8_LDB(B1, 1, 1); PG8_SCHED; PG8_LDA(At, 1, 0); PG8_STAGE(PG8_SA(0, 1), a2 + hstep, voffA);
            PG8_WAIT_V(8); PG8_WAIT_L(0); PG8_BAR; PG8_MMA(0, 0, At, B0); PG8_MMA(0, 1, At, B1); PG8_BAR; PG8_SCHED;
            PG8_LDA(At, 1, 1); PG8_STAGE(PG8_SB(1, 0), b3, voffB); PG8_STAGE(PG8_SB(1, 1), b3 + hstep, voffB); PG8_STAGE(PG8_SA(1, 0), a3, voffA);
            PG8_WAIT_V(8); PG8_WAIT_L(0); PG8_BAR; PG8_MMA(1, 0, At, B0); PG8_MMA(1, 1, At, B1); PG8_BAR; PG8_SCHED;
            } else {
            PG8_LDB(B0, 0, 0); PG8_SCHED; PG8_LDA(At, 0, 0); PG8_STAGE(PG8_SA(1, 1), a1 + hstep, voffA);
            PG8_WAIT_L(8); PG8_BAR; PG8_WAIT_L(0); PG8_MMA(0, 0, At, B0); PG8_BAR; PG8_SCHED;
            PG8_LDB(B1, 0, 1); PG8_STAGE(PG8_SB(0, 0), b2, voffB);
            PG8_BAR; PG8_WAIT_L(0); PG8_MMA(0, 1, At, B1); PG8_BAR;
            PG8_LDA(At, 0, 1); PG8_STAGE(PG8_SA(0, 0), a2, voffA);
            PG8_BAR; PG8_WAIT_L(0); PG8_MMA(1, 0, At, B0); PG8_BAR; PG8_SCHED;
            PG8_STAGE(PG8_SB(0, 1), b2 + hstep, voffB);
            PG8_WAIT_V(6); PG8_BAR; PG8_MMA(1, 1, At, B1); PG8_BAR;
            PG8_LDB(B0, 1, 0); PG8_SCHED; PG8_LDA(At, 1, 0); PG8_STAGE(PG8_SA(0, 1), a2 + hstep, voffA);
            PG8_WAIT_L(8); PG8_BAR; PG8_WAIT_L(0); PG8_MMA(0, 0, At, B0); PG8_BAR; PG8_SCHED;
            PG8_LDB(B1, 1, 1); PG8_STAGE(PG8_SB(1, 0), b3, voffB);
            PG8_BAR; PG8_WAIT_L(0); PG8_MMA(0, 1, At, B1); PG8_BAR;
            PG8_LDA(At, 1, 1); PG8_STAGE(PG8_SA(1, 0), a3, voffA);
            PG8_BAR; PG8_WAIT_L(0); PG8_MMA(1, 0, At, B0); PG8_BAR; PG8_SCHED;
            PG8_STAGE(PG8_SB(1, 1), b3 + hstep, voffB);
            PG8_WAIT_V(6); PG8_BAR; PG8_MMA(1, 1, At, B1); PG8_BAR;
            }
        }
        if constexpr (ALIGN_EPI) { if (wr == 0) PG8_BAR; }
        if constexpr (!Epi::AFTER_DRAIN) { E(acc, cur, wr, wc, fr, fq); S.done(cur); }
        if (!has_next) break;
#pragma unroll
        for (int a = 0; a < 2; ++a)
#pragma unroll
            for (int b = 0; b < 2; ++b)
#pragma unroll
                for (int m = 0; m < 4; ++m)
#pragma unroll
                    for (int n = 0; n < 2; ++n) acc[a][b][m][n] = (f32x4){0.f, 0.f, 0.f, 0.f};
        cur = nxt; cA = nA; cB = nB; ++ui;
        if constexpr (ALIGN_EPI) { if (wr == 1) PG8_BAR; }
    }
    PG8_WAIT_V(0);
    if constexpr (!ALIGN_EPI) { if (wr == 0) PG8_BAR; }
    PG8_BAR;
    if constexpr (Epi::AFTER_DRAIN) { E.fused(acc, cur, wr, wc, fr, fq, lds, wid, lane); S.done(cur); }
#undef PG8_SA
#undef PG8_SB
#undef PG8_STAGE
#undef PG8_LDA
#undef PG8_LDB
#undef PG8_MMA
#undef PG8_WAIT_V
#undef PG8_WAIT_L
#undef PG8_BAR
#undef PG8_SCHED
}
}

#define DI __device__ __forceinline__
#define LAS __attribute__((address_space(3)))
typedef unsigned short bf16;
typedef float f32x4 __attribute__((ext_vector_type(4)));
typedef float f32x16 __attribute__((ext_vector_type(16)));
typedef short bf16x8 __attribute__((ext_vector_type(8)));
typedef short s16x4 __attribute__((ext_vector_type(4)));
typedef unsigned u32x4 __attribute__((ext_vector_type(4)));
typedef unsigned u32x2 __attribute__((ext_vector_type(2)));
using pg8::pk_bf16; using pg8::bf16_1;

constexpr int NWAVES = 8, NTHR = 512;
constexpr int LDS_BYTES = 147456;
constexpr int D = 1024, MX = 16384, MC = 512, MALL = MX + MC, SEQ = 8192, CTX = 256, NKEY = 8448, FF = 4096;
constexpr float LN_EPS = 1e-5f;
constexpr float ALPHA = 1.41421356237309515f;
constexpr size_t MiB = 1u << 20;
constexpr size_t WS_MODP = 0;
constexpr size_t WS_MOD = 2 * MiB + 256 * 1024;
constexpr size_t WS_ROPE = 2 * MiB + 512 * 1024;
constexpr size_t WS_ST1 = 7 * MiB + 256 * 1024, WS_ST2 = WS_ST1 + 128 * 1024;
constexpr size_t WS_BAR = 2 * MiB + 768 * 1024;
constexpr size_t WS_E = 3 * MiB;
constexpr size_t WS_XC = 8 * MiB;
constexpr size_t WS_WIN0 = 10 * MiB;
constexpr size_t WS_WOUT = 16 * MiB;
constexpr size_t WS_W1 = 20 * MiB;
constexpr size_t WS_W2 = 36 * MiB;
constexpr size_t WS_WCD = 52 * MiB;
constexpr size_t WS_WGLU = 55 * MiB;
constexpr size_t WS_H = 56 * MiB;
constexpr size_t WS_Y = 89 * MiB;
constexpr size_t WS_BIG = 122 * MiB;
constexpr size_t WS_Q = WS_BIG, WS_K = WS_BIG + 25 * MiB, WS_VT = WS_BIG + 50 * MiB, WS_FG = WS_BIG + 75 * MiB;
constexpr size_t WS_S = WS_BIG, WS_U = WS_BIG + 33 * MiB, WS_V = WS_BIG + 66 * MiB, WS_GA = WS_BIG + 99 * MiB;
constexpr size_t WS_END = 254 * MiB;

struct Args { const float* in[35]; float* out; unsigned char* ws; int ph_lo, ph_hi; };

DI float wave_sum(float v) {
#pragma unroll
    for (int o = 1; o < 64; o <<= 1) v += __shfl_xor(v, o);
    return v;
}
#define LDS_WAIT() asm volatile("s_waitcnt lgkmcnt(0)" ::: "memory")

DI void transpose_item(const float* W, int K, int N, bf16* WT, int row_off, float* scr, int kb, int nb, int lane) {
    const int k0 = 64 * kb, n0 = 32 * nb;
    float tv[32];
#pragma unroll
    for (int i = 0; i < 32; ++i) { const int kk = 2 * i + (lane >> 5); tv[i] = W[(size_t)(k0 + kk) * N + n0 + (lane & 31)]; }
#pragma unroll
    for (int i = 0; i < 32; ++i) { const int kk = 2 * i + (lane >> 5); scr[kk * 33 + (lane & 31)] = tv[i]; }
    LDS_WAIT(); asm volatile("" ::: "memory");
    const int c = lane & 7;
#pragma unroll
    for (int j = 0; j < 4; ++j) { const int n = (lane >> 3) + 8 * j; const float* s = scr + (8 * c) * 33 + n;
        u32x4 o; o.x = pk_bf16(s[0 * 33], s[1 * 33]); o.y = pk_bf16(s[2 * 33], s[3 * 33]); o.z = pk_bf16(s[4 * 33], s[5 * 33]); o.w = pk_bf16(s[6 * 33], s[7 * 33]);
        *(u32x4*)(WT + (size_t)(row_off + n0 + n) * K + k0 + 8 * c) = o; }
    LDS_WAIT(); asm volatile("" ::: "memory");
}

#define XB_TMO      128
#define XB_XCNT(j)  (256  + 64 * (j))
#define XB_XSUB(j)  (1280 + 64 * (j))
#define XB_XGEN(j)  (2304 + 64 * (j))
#define XB_TOP      3328
#define XB_TOPGEN   3392
#define XCD_BAR_WORDS 3456
#define XB_SPIN_CAP (1u << 18)

__device__ __forceinline__ unsigned xb_ld(unsigned* p)              { return __hip_atomic_load(p, __ATOMIC_RELAXED, __HIP_MEMORY_SCOPE_AGENT); }
__device__ __forceinline__ unsigned xb_add(unsigned* p, unsigned v) { return __hip_atomic_fetch_add(p, v, __ATOMIC_RELAXED, __HIP_MEMORY_SCOPE_AGENT); }
__device__ __forceinline__ unsigned xb_xcc_id() { return (unsigned)__builtin_amdgcn_s_getreg((3 << 11) | 20) & 0xFu; }
#define XB_SPIN(cond, bar) do { unsigned _sp = 0; while (cond) { __builtin_amdgcn_s_sleep(1); \
    if ((++_sp & 255u) == 0u) { if (xb_ld(&(bar)[XB_TMO])) break; if (_sp > XB_SPIN_CAP) { atomicAdd(&(bar)[XB_TMO], 1u); break; } } } } while (0)

struct XcdBarrier {
    unsigned* bar; unsigned x;
    volatile LAS unsigned* st;
};

__device__ __forceinline__ XcdBarrier xcd_barrier_post(unsigned* bar, volatile LAS unsigned* st) {
    XcdBarrier b; b.bar = bar; b.x = xb_xcc_id(); b.st = st;
    if (threadIdx.x == 0) (void)xb_add(&bar[XB_XCNT(b.x)], 1u);
    return b;
}
__device__ __forceinline__ void xcd_barrier_complete(unsigned* bar, unsigned x, unsigned& nloc, unsigned& nx) {
    const unsigned G = gridDim.x * gridDim.y * gridDim.z;
    unsigned sum, cnt, mine, sp = 0u;
    for (;;) {
        sum = 0u; cnt = 0u; mine = 0u;
#pragma unroll
        for (unsigned j = 0; j < 16; ++j) { const unsigned c = xb_ld(&bar[XB_XCNT(j)]); sum += c; cnt += (c > 0u) ? 1u : 0u; mine = (j == x) ? c : mine; }
        if (sum == G) break;
        __builtin_amdgcn_s_sleep(1);
        if ((++sp & 255u) == 0u) { if (xb_ld(&bar[XB_TMO])) break; if (sp > XB_SPIN_CAP) { atomicAdd(&bar[XB_TMO], 1u); break; } }
    }
    nloc = mine > 0u ? mine : 1u; nx = cnt > 0u ? cnt : 1u;
}

__device__ __forceinline__ void xcd_barrier(const XcdBarrier& b) {
    asm volatile("s_waitcnt vmcnt(0)" ::: "memory");
    __syncthreads();
    if (threadIdx.x == 0) {
        unsigned* bar = b.bar;
        __builtin_amdgcn_s_waitcnt(0);
        unsigned nloc = b.st[0], nx = b.st[1];
        if (nloc == 0u) { xcd_barrier_complete(bar, b.x, nloc, nx); b.st[0] = nloc; b.st[1] = nx; }
        const unsigned old = xb_add(&bar[XB_XSUB(b.x)], 1u);
        const unsigned gen = old / nloc;
        if (old + 1u == (gen + 1u) * nloc) {
            __builtin_amdgcn_fence(__ATOMIC_RELEASE, "agent");
            asm volatile("s_waitcnt vmcnt(0)" ::: "memory");
            const unsigned og = xb_add(&bar[XB_TOP], 1u);
            const unsigned tg = og / nx;
            if (og + 1u == (tg + 1u) * nx) xb_add(&bar[XB_TOPGEN], 1u);
            else XB_SPIN(xb_ld(&bar[XB_TOPGEN]) == tg, bar);
            __builtin_amdgcn_fence(__ATOMIC_ACQUIRE, "agent");
            xb_add(&bar[XB_XGEN(b.x)], 1u);
            asm volatile("s_waitcnt vmcnt(0)" ::: "memory");
        } else {
            XB_SPIN(xb_ld(&bar[XB_XGEN(b.x)]) == gen, bar);
            __builtin_amdgcn_fence(__ATOMIC_ACQUIRE, "agent");
            asm volatile("s_waitcnt vmcnt(0)" ::: "memory");
        }
    }
    __syncthreads();
}

DI void ln_phase(const float* src_x, const float* src_c, float* dst_x, float* dst_c, int nrows, const float* g, const float* bta,
                 const float* mod_sh, const float* mod_sc, bf16* H, int gw, int ngw, int lane, const float* cg = nullptr, const float* cb = nullptr, const float* part = nullptr, int nparts = 0, float* stats = nullptr) {
    for (int row = gw; row < nrows; row += ngw) {
        const bool isx = row < MX; const int v = isx ? (row >> 13) : 2;
        const float* sp = isx ? src_x + (size_t)row * D : src_c + (size_t)(row - MX) * D;
        f32x4 x[4]; float s = 0.f;
#pragma unroll
        for (int j = 0; j < 4; ++j) { x[j] = *(const f32x4*)(sp + (lane + 64 * j) * 4);
            if (part && !isx) for (int k = 0; k < nparts; ++k) x[j] = x[j] + *(const f32x4*)(part + ((size_t)k * 512 + (row - MX)) * D + (lane + 64 * j) * 4);
            s += (x[j][0] + x[j][1]) + (x[j][2] + x[j][3]); }
        float mean = wave_sum(s) * (1.f / D), s2 = 0.f;
#pragma unroll
        for (int j = 0; j < 4; ++j) { x[j] = x[j] - mean; s2 += (x[j][0] * x[j][0] + x[j][1] * x[j][1]) + (x[j][2] * x[j][2] + x[j][3] * x[j][3]); }
        float rstd = rsqrtf(wave_sum(s2) * (1.f / D) + LN_EPS);
        if (!g && cg && !isx) {
            float* dp = dst_c + (size_t)(row - MX) * D;
#pragma unroll
            for (int j = 0; j < 4; ++j) { const int c = (lane + 64 * j) * 4; *(f32x4*)(dp + c) = (x[j] + mean) * ALPHA + *(const f32x4*)(cg + c) * *(const f32x4*)(cb + c); }
        }
        if (g) {
            if (stats && isx && lane == 0) { stats[2 * row] = mean; stats[2 * row + 1] = rstd; }
            float* dp = isx ? dst_x + (size_t)row * D : dst_c + (size_t)(row - MX) * D;
            s = 0.f;
#pragma unroll
            for (int j = 0; j < 4; ++j) { const int c = (lane + 64 * j) * 4; x[j] = x[j] * rstd * *(const f32x4*)(g + c) + *(const f32x4*)(bta + c);
                if (!(stats && isx)) *(f32x4*)(dp + c) = (cg && !isx) ? x[j] * ALPHA + *(const f32x4*)(cg + c) * *(const f32x4*)(cb + c) : x[j];
                s += (x[j][0] + x[j][1]) + (x[j][2] + x[j][3]); }
            if (H) {
                mean = wave_sum(s) * (1.f / D); s2 = 0.f;
#pragma unroll
                for (int j = 0; j < 4; ++j) { x[j] = x[j] - mean; s2 += (x[j][0] * x[j][0] + x[j][1] * x[j][1]) + (x[j][2] * x[j][2] + x[j][3] * x[j][3]); }
                rstd = rsqrtf(wave_sum(s2) * (1.f / D) + LN_EPS);
            }
        }
        if (H) {
            bf16* hp = H + (size_t)row * D;
#pragma unroll
            for (int j = 0; j < 4; ++j) { const int c = (lane + 64 * j) * 4;
                const f32x4 sc = *(const f32x4*)(mod_sc + v * 6144 + c), sh = *(const f32x4*)(mod_sh + v * 6144 + c);
                const f32x4 h = x[j] * rstd * (sc + 1.f) + sh;
                *(u32x2*)(hp + c) = (u32x2){pk_bf16(h[0], h[1]), pk_bf16(h[2], h[3])}; }
        }
    }
}

namespace att {
constexpr int OP = 132;
#define MFMA32(a, b, c) __builtin_amdgcn_mfma_f32_32x32x16_bf16((a), (b), (c), 0, 0, 0)
DI int crow(int i, int h) { return (i & 3) + 8 * (i >> 2) + 4 * h; }

template <int VAR = 0>
DI void attn_unit(unsigned char* lds, const bf16* Q, const bf16* Kb, const bf16* Vt, bf16* Y, int b, int hh, int qrow0, int nkeys, float lam, const float* subg,
                  int tid, int wave, int lane, int yrow0 = -1) {
    if (yrow0 < 0) yrow0 = qrow0;
    const int map = wave >> 2, qsub = wave & 3, r = lane & 31, h = lane >> 5;
    const unsigned char* kvbase = (const unsigned char*)(Kb + (size_t)(b * 6 + hh) * 132 * 16384);
    (void)Vt;
    constexpr int TILE_B = 32768;
    auto issue = [&](int t) __attribute__((always_inline)) {
        const unsigned char* src = kvbase + (size_t)t * TILE_B + wave * 1024 + lane * 16;
        LAS unsigned char* dst = (LAS unsigned char*)lds + (t & 3) * TILE_B + wave * 1024;
#pragma unroll
        for (int i = 0; i < 4; ++i) __builtin_amdgcn_global_load_lds((const unsigned*)(src + i * 8192), (LAS unsigned*)(dst + i * 8192), 16, 0, 0);
    };
    int offs[4];
#pragma unroll
    for (int s = 0; s < 4; ++s) offs[s] = r * 128 + ((((2 * s + h) ^ ((r >> 1) & 7))) << 4);
    bf16x8 qf[4];
    { const bf16* qp = Q + (size_t)(qrow0 + qsub * 32 + r) * 768 + hh * 128 + map * 64 + 8 * h;
#pragma unroll
      for (int s = 0; s < 4; ++s) qf[s] = *(const bf16x8*)(qp + 16 * s); }
    f32x16 O[4];
#pragma unroll
    for (int e = 0; e < 4; ++e)
#pragma unroll
        for (int i = 0; i < 16; ++i) O[e][i] = 0.f;
    float mrun = -INFINITY, lrun = 0.f;
    const int nt = nkeys >> 6;
#define ATT_BAR() do { __builtin_amdgcn_sched_barrier(0); asm volatile("s_waitcnt lgkmcnt(0)\n\ts_barrier" ::: "memory"); __builtin_amdgcn_sched_barrier(0); } while (0)
#define ATT_VMWAIT(younger_exists) do { if (younger_exists) asm volatile("s_waitcnt vmcnt(4)" ::: "memory"); else asm volatile("s_waitcnt vmcnt(0)" ::: "memory"); } while (0)
#define ATT_QK(slot_t) do { const unsigned char* kt_ = lds + ((slot_t) & 3) * TILE_B + map * 8192; bf16x8 kf0[4], kf1[4]; \
        _Pragma("unroll") for (int s = 0; s < 4; ++s) { kf0[s] = *(const bf16x8*)(kt_ + offs[s]); kf1[s] = *(const bf16x8*)(kt_ + 4096 + offs[s]); } \
        __builtin_amdgcn_sched_barrier(0); \
        _Pragma("unroll") for (int i = 0; i < 16; ++i) { x0[i] = 0.f; x1[i] = 0.f; } \
        _Pragma("unroll") for (int s = 0; s < 4; ++s) { x0 = MFMA32(kf0[s], qf[s], x0); x1 = MFMA32(kf1[s], qf[s], x1); } } while (0)
#define ATT_PINX() do { \
        asm volatile("" : "+v"(x0[0]), "+v"(x0[1]), "+v"(x0[2]), "+v"(x0[3]), "+v"(x0[4]), "+v"(x0[5]), "+v"(x0[6]), "+v"(x0[7]), "+v"(x0[8]), "+v"(x0[9]), "+v"(x0[10]), "+v"(x0[11]), "+v"(x0[12]), "+v"(x0[13]), "+v"(x0[14]), "+v"(x0[15])); \
        asm volatile("" : "+v"(x1[0]), "+v"(x1[1]), "+v"(x1[2]), "+v"(x1[3]), "+v"(x1[4]), "+v"(x1[5]), "+v"(x1[6]), "+v"(x1[7]), "+v"(x1[8]), "+v"(x1[9]), "+v"(x1[10]), "+v"(x1[11]), "+v"(x1[12]), "+v"(x1[13]), "+v"(x1[14]), "+v"(x1[15])); } while (0)
    f32x16 x0, x1;
    asm volatile("s_waitcnt vmcnt(0)" ::: "memory");
    issue(0); issue(1); issue(2);
    asm volatile("s_waitcnt vmcnt(4)" ::: "memory");
    __syncthreads();
    ATT_QK(0);
    ATT_PINX();
    if (map == 1) ATT_BAR();
#pragma unroll 1
    for (int t = 0; t < nt; ++t) {
        if (VAR != 3 && map == 1 && t + 3 < nt) issue(t + 3);
        float tm = x0[0];
#pragma unroll
        for (int i = 1; i < 16; ++i) tm = fmaxf(tm, x0[i]);
#pragma unroll
        for (int i = 0; i < 16; ++i) tm = fmaxf(tm, x1[i]);
        tm = fmaxf(tm, __shfl_xor(tm, 32));
        const float mnew = fmaxf(mrun, tm);
        if (__ballot(mnew > mrun + 12.f) != 0ull) {
            const float al = __builtin_amdgcn_exp2f(mrun - mnew);
            lrun *= al;
#pragma unroll
            for (int e = 0; e < 4; ++e)
#pragma unroll
                for (int i = 0; i < 16; ++i) O[e][i] *= al;
            mrun = mnew;
        }
        float ps0 = 0.f, ps1 = 0.f;
#pragma unroll
        for (int i = 0; i < 16; ++i) { if (VAR == 1) { x0[i] = x0[i] - mrun; x1[i] = x1[i] - mrun; } else { x0[i] = __builtin_amdgcn_exp2f(x0[i] - mrun); x1[i] = __builtin_amdgcn_exp2f(x1[i] - mrun); } ps0 += x0[i]; ps1 += x1[i]; }
        lrun += ps0 + ps1;
        u32x4 pw[4];
#pragma unroll
        for (int st = 0; st < 2; ++st) {
            const int o = 8 * st;
            pw[st].x = pk_bf16(x0[o], x0[o + 1]); pw[st].y = pk_bf16(x0[o + 2], x0[o + 3]); pw[st].z = pk_bf16(x0[o + 4], x0[o + 5]); pw[st].w = pk_bf16(x0[o + 6], x0[o + 7]);
            pw[2 + st].x = pk_bf16(x1[o], x1[o + 1]); pw[2 + st].y = pk_bf16(x1[o + 2], x1[o + 3]); pw[2 + st].z = pk_bf16(x1[o + 4], x1[o + 5]); pw[2 + st].w = pk_bf16(x1[o + 6], x1[o + 7]);
        }
        asm volatile("" : "+v"(pw[0].x), "+v"(pw[0].y), "+v"(pw[0].z), "+v"(pw[0].w), "+v"(pw[1].x), "+v"(pw[1].y), "+v"(pw[1].z), "+v"(pw[1].w),
                          "+v"(pw[2].x), "+v"(pw[2].y), "+v"(pw[2].z), "+v"(pw[2].w), "+v"(pw[3].x), "+v"(pw[3].y), "+v"(pw[3].z), "+v"(pw[3].w), "+v"(lrun));
        if (map == 0) ATT_VMWAIT(t + 2 < nt);
        ATT_BAR();
        if (VAR != 3 && map == 0 && t + 3 < nt) issue(t + 3);
        {
            const unsigned char* vt = lds + (t & 3) * TILE_B + 16384;
#define ATT_VLD(dst, st) do { _Pragma("unroll") for (int eb = 0; eb < 4; ++eb) dst[eb] = *(const bf16x8*)(vt + eb * 4096 + offs[st]); } while (0)
#define ATT_PV(src, st) do { const bf16x8 pf = __builtin_bit_cast(bf16x8, pw[st]); _Pragma("unroll") for (int eb = 0; eb < 4; ++eb) { if (VAR == 2) { O[eb][0] += (float)src[eb][0] * (float)pf[0]; } else O[eb] = MFMA32(src[eb], pf, O[eb]); } } while (0)
            bf16x8 va[4], vb[4];
            ATT_VLD(va, 0); ATT_VLD(vb, 1);
            __builtin_amdgcn_sched_barrier(0);
            ATT_PV(va, 0);
            __builtin_amdgcn_sched_barrier(0);
            ATT_VLD(va, 2);
            __builtin_amdgcn_sched_barrier(0);
            ATT_PV(vb, 1);
            __builtin_amdgcn_sched_barrier(0);
            ATT_VLD(vb, 3);
            __builtin_amdgcn_sched_barrier(0);
            ATT_PV(va, 2);
            ATT_PV(vb, 3);
        }
        __builtin_amdgcn_sched_barrier(0);
        if (t + 1 < nt) { ATT_QK(t + 1); }
        ATT_PINX();
        if (map == 1) ATT_VMWAIT(t + 3 < nt);
        ATT_BAR();
    }
    if (map == 0) ATT_BAR();
    asm volatile("s_waitcnt vmcnt(0)" ::: "memory");
    __syncthreads();
    const float lt = lrun + __shfl_xor(lrun, 32), inv = 1.f / lt;
    float* ob = (float*)lds;
    if (map == 1) {
#pragma unroll
        for (int eb = 0; eb < 4; ++eb)
#pragma unroll
            for (int i4 = 0; i4 < 4; ++i4) {
                f32x4 v = {O[eb][4 * i4] * inv, O[eb][4 * i4 + 1] * inv, O[eb][4 * i4 + 2] * inv, O[eb][4 * i4 + 3] * inv};
                *(f32x4*)(ob + (qsub * 32 + r) * OP + 32 * eb + 8 * i4 + 4 * h) = v;
            }
    }
    __syncthreads();
    if (map == 0) {
        float ss = 0.f;
#pragma unroll
        for (int eb = 0; eb < 4; ++eb)
#pragma unroll
            for (int i4 = 0; i4 < 4; ++i4) {
                const f32x4 o1 = *(const f32x4*)(ob + (qsub * 32 + r) * OP + 32 * eb + 8 * i4 + 4 * h);
#pragma unroll
                for (int j = 0; j < 4; ++j) { const float d = O[eb][4 * i4 + j] * inv - lam * o1[j]; O[eb][4 * i4 + j] = d; ss += d * d; }
            }
        ss += __shfl_xor(ss, 32);
        const float rn = rsqrtf(ss * (1.f / 128.f) + LN_EPS) * 0.8f;
        bf16* yp = Y + (size_t)(yrow0 + qsub * 32 + r) * D + 256 + hh * 128;
#pragma unroll
        for (int eb = 0; eb < 4; ++eb)
#pragma unroll
            for (int i4 = 0; i4 < 4; ++i4) {
                const int e = 32 * eb + 8 * i4 + 4 * h;
                const f32x4 g = *(const f32x4*)(subg + e);
                *(u32x2*)(yp + e) = (u32x2){pk_bf16(O[eb][4 * i4] * rn * g[0], O[eb][4 * i4 + 1] * rn * g[1]), pk_bf16(O[eb][4 * i4 + 2] * rn * g[2], O[eb][4 * i4 + 3] * rn * g[3])};
            }
    }
    __syncthreads();
}
}

DI void fft_lds_cols64(float2* X, const float2* TW, int logN, int tid) {
    const int N = 1 << logN, nb = (N >> 1) * 64;
    for (int s = 1; s <= logN; ++s) {
        const int half = 1 << (s - 1), tsh = 7 - s;
#pragma unroll 4
        for (int t = tid; t < nb; t += NTHR) {
            const int c = t & 63, bf = t >> 6, j = bf & (half - 1), grp = bf >> (s - 1);
            const int i0 = (grp << s) + j, i1 = i0 + half;
            const float2 w = TW[j << tsh];
            const float2 a = X[i0 * 64 + c], bq = X[i1 * 64 + c];
            const float tr = w.x * bq.x - w.y * bq.y, ti = w.x * bq.y + w.y * bq.x;
            X[i0 * 64 + c] = make_float2(a.x + tr, a.y + ti); X[i1 * 64 + c] = make_float2(a.x - tr, a.y - ti);
        }
        __syncthreads();
    }
}
DI int bitrev(int v, int bits) { return (int)(__brev((unsigned)v) >> (32 - bits)); }
constexpr int FFT_TW_OFF = 65536, FFT_TW2_OFF = 65536 + 512;

template <int logN1>
DI void fft_step1(unsigned char* lds, const float* FG, unsigned* T, int bg, int g, int rowbase, int n2, int tid) {
    float2* X = (float2*)lds; float2* TW = (float2*)(lds + FFT_TW_OFF); float2* TW2 = (float2*)(lds + FFT_TW2_OFF); constexpr int N1 = 1 << logN1;
    if (tid < 64) { float sn, cs; sincospif(-(float)tid * (1.f / 64.f), &sn, &cs); TW[tid] = make_float2(cs, sn); }
    else if (tid < 64 + N1) { const int k1 = tid - 64; float sn, cs; sincospif(-2.f * (float)(n2 * k1) / (float)(64 * N1), &sn, &cs); TW2[k1] = make_float2(cs, sn); }
    {
        constexpr int NIT = (N1 * 64 + NTHR - 1) / NTHR;
        float vr[NIT], vi[NIT];
#pragma unroll
        for (int i = 0; i < NIT; ++i) { const int t = tid + i * NTHR; if (t < N1 * 64) { const int c = t & 63, n1 = t >> 6; const float* p = FG + (size_t)(rowbase + 64 * n1 + n2) * 512 + g * 128 + c; vr[i] = p[0]; vi[i] = p[64]; } }
#pragma unroll
        for (int i = 0; i < NIT; ++i) { const int t = tid + i * NTHR; if (t < N1 * 64) { const int c = t & 63, n1 = t >> 6; X[bitrev(n1, logN1) * 64 + c] = make_float2(vr[i], vi[i]); } }
    }
    __syncthreads();
    fft_lds_cols64(X, TW, logN1, tid);
    for (int t = tid; t < N1 * 64; t += NTHR) { const int c = t & 63, k1 = t >> 6; const float2 w = TW2[k1];
        const float2 a = X[k1 * 64 + c];
        T[((size_t)(bg * N1 + k1) * 64 + n2) * 64 + c] = pk_bf16(a.x * w.x - a.y * w.y, a.x * w.y + a.y * w.x); }
    __syncthreads();
}
DI void fft_step3(unsigned char* lds, const unsigned* T, bf16* Y, int bg, int g, int rowbase, int k1, int N1, float scale, int tid) {
    float2* X = (float2*)lds; float2* TW = (float2*)(lds + FFT_TW_OFF);
    if (tid < 64) { float sn, cs; sincospif(-(float)tid * (1.f / 64.f), &sn, &cs); TW[tid] = make_float2(cs, sn); }
    {
        float2 v[8];
#pragma unroll
        for (int i = 0; i < 8; ++i) { const int t = tid + i * NTHR, c = t & 63, n2 = t >> 6; const unsigned w = T[((size_t)(bg * N1 + k1) * 64 + n2) * 64 + c];
            v[i] = make_float2(__builtin_bit_cast(float, w << 16), __builtin_bit_cast(float, w & 0xffff0000u)); }
#pragma unroll
        for (int i = 0; i < 8; ++i) { const int t = tid + i * NTHR, c = t & 63, n2 = t >> 6; X[bitrev(n2, 6) * 64 + c] = v[i]; }
    }
    __syncthreads();
    fft_lds_cols64(X, TW, 6, tid);
    for (int t = tid; t < 64 * 64; t += NTHR) { const int c = t & 63, k2 = t >> 6; Y[(size_t)(rowbase + k1 + N1 * k2) * D + g * 64 + c] = bf16_1(X[k2 * 64 + c].x * scale); }
    __syncthreads();
}

struct S5Lane { float ar, ai; float br[16], bi[16]; };
DI void s5_lane_params(S5Lane& P, const float* lam_re, const float* lam_im, const float* log_dt, const float* b_re, const float* b_im, int r, int g, int p) {
    const int gi = r * 32 + g; const float lr = lam_re[gi * 64 + p], li = lam_im[gi * 64 + p], dt = expf(log_dt[gi]);
    const float mag = expf(lr * dt); float sn, cs; sincosf(li * dt, &sn, &cs);
    P.ar = mag * cs; P.ai = mag * sn;
    const float nr = P.ar - 1.f, ni = P.ai, den = 1.f / (lr * lr + li * li);
    const float fr = (nr * lr + ni * li) * den, fi = (ni * lr - nr * li) * den;
#pragma unroll
    for (int i = 0; i < 16; ++i) { const float xr = b_re[(size_t)(gi * 64 + p) * 16 + i], xi = b_im[(size_t)(gi * 64 + p) * 16 + i]; P.br[i] = fr * xr - fi * xi; P.bi[i] = fr * xi + fi * xr; }
}
DI int s5_chunk_row(int b, int c) { return c < 2 ? MX + b * 256 + c * 128 : b * SEQ + (c - 2) * 128; }
DI void s5_stage_u(float* ul, const float* S, int row0, int g, int lane) {
#pragma unroll
    for (int it = 0; it < 8; ++it) { const int t = it * 16 + (lane >> 2), q = lane & 3; *(f32x4*)(ul + t * 16 + q * 4) = *(const f32x4*)(S + (size_t)(row0 + t) * 512 + g * 16 + q * 4); }
    LDS_WAIT(); asm volatile("" ::: "memory");
}
DI void s5_step(const S5Lane& P, const float* ut, float& hr, float& hi) {
    float br = 0.f, bi = 0.f;
#pragma unroll
    for (int q = 0; q < 4; ++q) { const f32x4 u = *(const f32x4*)(ut + 4 * q);
#pragma unroll
        for (int j = 0; j < 4; ++j) { br += P.br[4 * q + j] * u[j]; bi += P.bi[4 * q + j] * u[j]; } }
    const float nr = P.ar * hr - P.ai * hi + br, ni = P.ar * hi + P.ai * hr + bi; hr = nr; hi = ni;
}
DI void s5_pass_a(float* wl, const float* S, float2* E, const float* const* in, int item, int lane) {
    const int c = item % 66, r = (item / 66) & 1, g = (item / 132) & 31, b = item / (132 * 32);
    S5Lane P; s5_lane_params(P, in[23], in[24], in[25], in[26], in[27], r, g, lane);
    s5_stage_u(wl, S, s5_chunk_row(b, c), g, lane);
    float hr = 0.f, hi = 0.f;
    for (int t = 0; t < 128; ++t) s5_step(P, wl + (r ? 127 - t : t) * 16, hr, hi);
    E[(size_t)(((b * 32 + g) * 2 + r) * 66 + c) * 64 + lane] = make_float2(hr, hi);
    LDS_WAIT(); asm volatile("" ::: "memory");
}
DI float gelu_tanh(float x) { const float z = 0.7978845608028654f * (x + 0.044715f * x * x * x); return x - x / (1.f + __expf(2.f * z)); }
DI void s5_pass_b(float* wl, const float* S, const float2* E, float* GF, bf16* GA, const float* const* in, int item, int lane) {
    typedef float f32x4v __attribute__((ext_vector_type(4)));
    const int c = item & 63, g = (item >> 6) & 31, b = item >> 11;
    float* ul = wl;
    unsigned char* hs = (unsigned char*)(wl + 2048);
    const int row0 = b * SEQ + c * 128, fr = lane & 15, fq = lane >> 4;
    s5_stage_u(ul, S, row0, g, lane);
    const float dsk = in[30][g * 16 + fr];
    f32x4v yf[8];
#pragma unroll 1
    for (int r = 0; r < 2; ++r) {
        S5Lane P; s5_lane_params(P, in[23], in[24], in[25], in[26], in[27], r, g, lane);
        bf16x8 cf[4];
#pragma unroll
        for (int ks = 0; ks < 4; ++ks) {
            const size_t o = (size_t)((r * 32 + g) * 16 + fr) * 64 + 16 * ks + 4 * fq;
            const f32x4v cr = *(const f32x4v*)(in[28] + o), ci = *(const f32x4v*)(in[29] + o);
            u32x4 w; w.x = pk_bf16(cr[0], -ci[0]); w.y = pk_bf16(cr[1], -ci[1]); w.z = pk_bf16(cr[2], -ci[2]); w.w = pk_bf16(cr[3], -ci[3]);
            cf[ks] = __builtin_bit_cast(bf16x8, w);
        }
        float pr = P.ar, pi = P.ai;
#pragma unroll
        for (int k = 0; k < 7; ++k) { const float nr = pr * pr - pi * pi, ni = 2.f * pr * pi; pr = nr; pi = ni; }
        const float2* Eb = E + (size_t)(((b * 32 + g) * 2 + r) * 66) * 64 + lane;
        float hr = 0.f, hi = 0.f;
        {
            const int n = r == 0 ? c + 2 : 65 - c;
#pragma unroll 1
            for (int k0 = 0; k0 < n; k0 += 8) {
                float2 e[8];
#pragma unroll
                for (int j = 0; j < 8; ++j) { const int k = k0 + j, q = r == 0 ? k : (k == 0 ? 1 : (k == 1 ? 0 : 67 - k)); e[j] = (k < n) ? Eb[q * 64] : make_float2(0.f, 0.f); }
#pragma unroll
                for (int j = 0; j < 8; ++j) if (k0 + j < n) { const float nr = pr * hr - pi * hi + e[j].x, ni = pr * hi + pi * hr + e[j].y; hr = nr; hi = ni; }
            }
        }
#pragma unroll
        for (int bk = 0; bk < 8; ++bk) {
            const int blkk = r ? 7 - bk : bk;
#pragma unroll 4
            for (int sidx = 0; sidx < 16; ++sidx) {
                const int tl = r ? 15 - sidx : sidx;
                s5_step(P, ul + (16 * blkk + tl) * 16, hr, hi);
                *(unsigned*)(hs + tl * 272 + lane * 4) = pk_bf16(hr, hi);
            }
            LDS_WAIT(); asm volatile("" ::: "memory");
            f32x4v acc = {0.f, 0.f, 0.f, 0.f};
#pragma unroll
            for (int ks = 0; ks < 4; ++ks) {
                const bf16x8 a = *(const bf16x8*)(hs + fr * 272 + ks * 64 + fq * 16);
                acc = __builtin_amdgcn_mfma_f32_16x16x32_bf16(a, cf[ks], acc, 0, 0, 0);
            }
            LDS_WAIT(); asm volatile("" ::: "memory");
            if (r == 0) {
                if (bk == 0) yf[0] = acc; if (bk == 1) yf[1] = acc; if (bk == 2) yf[2] = acc; if (bk == 3) yf[3] = acc;
                if (bk == 4) yf[4] = acc; if (bk == 5) yf[5] = acc; if (bk == 6) yf[6] = acc; if (bk == 7) yf[7] = acc;
            } else {
                const f32x4v f = bk == 0 ? yf[7] : bk == 1 ? yf[6] : bk == 2 ? yf[5] : bk == 3 ? yf[4] : bk == 4 ? yf[3] : bk == 5 ? yf[2] : bk == 6 ? yf[1] : yf[0];
#pragma unroll
                for (int j = 0; j < 4; ++j) {
                    const int t = 16 * blkk + 4 * fq + j;
                    const float tot = dsk * ul[t * 16 + fr] + f[j] + acc[j], gg = gelu_tanh(tot);
                    GA[(size_t)(row0 + t) * 512 + g * 16 + fr] = bf16_1(gg);
                }
            }
        }
        LDS_WAIT(); asm volatile("" ::: "memory");
    }
}

DI void gmlp_item(unsigned char* lds, const float* U, const float* V, const float* wsp, const float* bsp, bf16* Y, int b, int n, int g, int tid, int wave, int lane) {
    typedef float f32x4v __attribute__((ext_vector_type(4)));
    unsigned char* vgT = lds;
    const int row0 = b * SEQ + n * 128, fr = lane & 15, fq = lane >> 4;
    bf16x8 wf[4];
    { const float* wp = wsp + (size_t)g * 16384 + (16 * wave + fr) * 128 + 8 * fq;
#pragma unroll
      for (int ks = 0; ks < 4; ++ks) { const f32x4v w0 = *(const f32x4v*)(wp + 32 * ks), w1 = *(const f32x4v*)(wp + 32 * ks + 4);
          u32x4 w; w.x = pk_bf16(w0[0], w0[1]); w.y = pk_bf16(w0[2], w0[3]); w.z = pk_bf16(w1[0], w1[1]); w.w = pk_bf16(w1[2], w1[3]); wf[ks] = __builtin_bit_cast(bf16x8, w); } }
    {
        float a0[16], a1[16], sm[16];
#pragma unroll
        for (int i = 0; i < 16; ++i) { const float* vp = V + (size_t)(row0 + 16 * wave + i) * 512 + g * 128; a0[i] = vp[lane]; a1[i] = vp[lane + 64]; sm[i] = a0[i] + a1[i]; }
#pragma unroll
        for (int o = 1; o < 64; o <<= 1) {
#pragma unroll
            for (int i = 0; i < 16; ++i) sm[i] += __shfl_xor(sm[i], o);
        }
#pragma unroll
        for (int i = 0; i < 16; ++i) { const float mean = sm[i] * (1.f / 128.f); a0[i] -= mean; a1[i] -= mean; sm[i] = a0[i] * a0[i] + a1[i] * a1[i]; }
#pragma unroll
        for (int o = 1; o < 64; o <<= 1) {
#pragma unroll
            for (int i = 0; i < 16; ++i) sm[i] += __shfl_xor(sm[i], o);
        }
#pragma unroll
        for (int i = 0; i < 16; ++i) { const float rstd = rsqrtf(sm[i] * (1.f / 128.f) + LN_EPS); a0[i] *= rstd; a1[i] *= rstd; }
#pragma unroll
        for (int i2 = 0; i2 < 8; ++i2) {
            *(unsigned*)(vgT + lane * 272 + (16 * wave + 2 * i2) * 2) = pk_bf16(a0[2 * i2], a0[2 * i2 + 1]);
            *(unsigned*)(vgT + (lane + 64) * 272 + (16 * wave + 2 * i2) * 2) = pk_bf16(a1[2 * i2], a1[2 * i2 + 1]);
        }
    }
    __syncthreads();
    f32x4v acc[8];
#pragma unroll
    for (int mb = 0; mb < 8; ++mb) {
        acc[mb] = (f32x4v){0.f, 0.f, 0.f, 0.f};
#pragma unroll
        for (int ks = 0; ks < 4; ++ks) {
            const bf16x8 a = *(const bf16x8*)(vgT + (16 * mb + fr) * 272 + 64 * ks + 16 * fq);
            acc[mb] = __builtin_amdgcn_mfma_f32_16x16x32_bf16(a, wf[ks], acc[mb], 0, 0, 0);
        }
    }
    const int p = 16 * wave + fr; const float bb = bsp[g * 128 + p];
#pragma unroll
    for (int mb = 0; mb < 8; ++mb) {
        const int c = 16 * mb + 4 * fq;
        const f32x4v u = *(const f32x4v*)(U + (size_t)(row0 + p) * 512 + g * 128 + c);
        *(u32x2*)(Y + (size_t)(row0 + p) * D + 512 + g * 128 + c) = (u32x2){pk_bf16(u[0] * (acc[mb][0] + bb), u[1] * (acc[mb][1] + bb)), pk_bf16(u[2] * (acc[mb][2] + bb), u[3] * (acc[mb][3] + bb))};
    }
    __syncthreads();
}

constexpr int N_PHASES = 20;
__global__ void __launch_bounds__(NTHR, 2) mega_fwd(Args args) {
    extern __shared__ __attribute__((aligned(16))) unsigned char lds[];
    cg::grid_group grid = cg::this_grid();
    const int tid = threadIdx.x, lane = tid & 63, wave = __builtin_amdgcn_readfirstlane(tid >> 6);
    const int G = gridDim.x, blk = blockIdx.x, gw = blk * NWAVES + wave, ngw = G * NWAVES;
    const int lo = args.ph_lo, hi = args.ph_hi;
    unsigned char* ws = args.ws;
    const float* const* in = args.in;
    float* XO = args.out;
    float* XC = (float*)(ws + WS_XC);
    float* MODP = (float*)(ws + WS_MODP); float* MOD = (float*)(ws + WS_MOD);
    float* ROPEC = (float*)(ws + WS_ROPE); float* ROPES = ROPEC + 2048;
    bf16* WIN0 = (bf16*)(ws + WS_WIN0); bf16* WOUT = (bf16*)(ws + WS_WOUT); bf16* W1 = (bf16*)(ws + WS_W1); bf16* W2 = (bf16*)(ws + WS_W2);
    bf16* WCD = (bf16*)(ws + WS_WCD); bf16* WGLU = (bf16*)(ws + WS_WGLU);
    bf16* H = (bf16*)(ws + WS_H); bf16* Y = (bf16*)(ws + WS_Y); bf16* ACT = (bf16*)(ws + WS_BIG);
    bf16* Qb = (bf16*)(ws + WS_Q); bf16* Kb = (bf16*)(ws + WS_K); bf16* Vt = (bf16*)(ws + WS_VT); float* FG = (float*)(ws + WS_FG);
    unsigned* TF = (unsigned*)(ws + WS_H);
    unsigned* TFC = TF + (size_t)8 * 128 * 4096;
    float* Sb = (float*)(ws + WS_S); float* Ub = (float*)(ws + WS_U); float* Vb = (float*)(ws + WS_V); bf16* GA = (bf16*)(ws + WS_GA); float* GF = (float*)(ws + WS_H);
    float2* Eb = (float2*)(ws + WS_E);
    PG8_LAS unsigned char* ldsp = (PG8_LAS unsigned char*)lds;
    volatile LAS unsigned* xst = (volatile LAS unsigned*)((LAS unsigned char*)lds + (LDS_BYTES - 64));
    if (tid < 2) xst[tid] = 0u;
    __syncthreads();
    XcdBarrier xbar; xbar.bar = (unsigned*)(ws + WS_BAR); xbar.x = 0; xbar.st = xst;
    if (hi - lo > 1) xbar = xcd_barrier_post((unsigned*)(ws + WS_BAR), xst);
#ifndef PHMASK
#define PHMASK 0xFFFFFu
#endif
#define IN(k) (((PHMASK >> ((k) > 14 ? (k) - 9 : (k))) & 1u) && lo <= (k) && (k) < hi)
#define SEAM(k) do { if ((k) + 1 < hi) { for (int rep_ = 0; rep_ < REP_SYNC; ++rep_) { xcd_barrier(xbar); } } } while (0)

    if (lo < 0) grid.sync();
    if (IN(0)) {
        for (int rep = 0; rep < REP_P01; ++rep) {
        for (int it = gw; it < 2 * 16 * 96; it += ngw) {
            const int cb = it % 96, ks = (it / 96) & 15, l = it / (96 * 16), n = cb * 64 + lane;
            const float* w = in[4] + (size_t)l * 1024 * 6144;
            float a0 = 0.f, a1 = 0.f, a2 = 0.f;
            float s0, s1, s2; { const float c0 = in[1][ks * 64 + lane], c1 = in[1][1024 + ks * 64 + lane], c2 = in[3][ks * 64 + lane];
                s0 = c0 / (1.f + __expf(-c0)); s1 = c1 / (1.f + __expf(-c1)); s2 = c2 / (1.f + __expf(-c2)); }
#pragma unroll 1
            for (int k0 = 0; k0 < 64; k0 += 16) {
                float wv[16];
#pragma unroll
                for (int kk = 0; kk < 16; ++kk) wv[kk] = w[(size_t)(ks * 64 + k0 + kk) * 6144 + n];
#pragma unroll
                for (int kk = 0; kk < 16; ++kk) { const int sl = k0 + kk;
                    a0 += __builtin_bit_cast(float, __builtin_amdgcn_readlane(__builtin_bit_cast(int, s0), sl)) * wv[kk]; a1 += __builtin_bit_cast(float, __builtin_amdgcn_readlane(__builtin_bit_cast(int, s1), sl)) * wv[kk];
                    a2 += __builtin_bit_cast(float, __builtin_amdgcn_readlane(__builtin_bit_cast(int, s2), sl)) * wv[kk]; }
            }
            float* pp = MODP + (size_t)((l * 16 + ks) * 3) * 6144 + n; pp[0] = a0; pp[6144] = a1; pp[2 * 6144] = a2;
        }
        for (int i = gw * 64 + lane; i < 2048; i += ngw * 64) { const int pos = i >> 4, f = i & 15; const float inv = powf(10000.f, -(float)f / 16.f), ang = (float)pos * inv;
            float sn, cs; sincosf(ang, &sn, &cs); ROPEC[i] = cs; ROPES[i] = sn; }
        {
            float* twt = (float*)lds + 8 * 2304;
            if (tid < 64) { twt[tid] = cospif((float)tid * (1.f / 32.f)); twt[64 + tid] = -sinpif((float)tid * (1.f / 32.f)); }
            __syncthreads();
            for (int it = gw; it < 512 * 16; it += ngw) {
                const int n = it >> 4, k = (it & 15) * 64 + lane, g = n >> 7, j = n & 127, jj = j & 63;
                const float* w = in[16] + (size_t)k * 2560 + g * 64; const float* tb = twt + (j < 64 ? 0 : 64); float a = 0.f;
#pragma unroll 4
                for (int c4 = 0; c4 < 64; c4 += 4) { const f32x4 wv = *(const f32x4*)(w + c4);
#pragma unroll
                    for (int e = 0; e < 4; ++e) a += wv[e] * tb[((c4 + e) * jj) & 63]; }
                WIN0[(size_t)n * 1024 + k] = bf16_1(a);
            }
            __syncthreads();
        }
        }
        SEAM(0);
    }
    if (IN(1)) {
        for (int rep = 0; rep < REP_P01; ++rep) {
        for (int i = gw * 64 + lane; i < 2 * 3 * 6144; i += ngw * 64) { const int n = i % 6144, v = (i / 6144) % 3, l = i / (3 * 6144);
            float a = in[5][l * 6144 + n];
            for (int ks = 0; ks < 16; ++ks) a += MODP[(size_t)((l * 16 + ks) * 3 + v) * 6144 + n];
            MOD[i] = a; }
        float* scr = (float*)lds + wave * 2304;
        constexpr int I_IN = 16 * 72, I_O = 16 * 32, I_1 = 16 * 128, I_2 = 64 * 32, I_CD = 16 * 48, I_GL = 8 * 16;
        constexpr int NIT = I_IN + 2 * I_O + 2 * I_1 + 2 * I_2 + I_CD + I_GL;
        for (int it = gw; it < NIT; it += ngw) {
            int r = it;
            if (r < I_IN) { transpose_item(in[16], 1024, 2560, WIN0, 256, scr, r / 72, 8 + r % 72, lane); continue; } r -= I_IN;
            if (r < 2 * I_O) { const int l = r / I_O; r %= I_O; transpose_item(in[6] + (size_t)l * D * D, D, D, WOUT + (size_t)l * D * D, 0, scr, r / 32, r % 32, lane); continue; } r -= 2 * I_O;
            if (r < 2 * I_1) { const int l = r / I_1; r %= I_1; transpose_item(in[10] + (size_t)l * D * FF, D, FF, W1 + (size_t)l * D * FF, 0, scr, r / 128, r % 128, lane); continue; } r -= 2 * I_1;
            if (r < 2 * I_2) { const int l = r / I_2; r %= I_2; transpose_item(in[12] + (size_t)l * D * FF, FF, D, W2 + (size_t)l * D * FF, 0, scr, r / 32, r % 32, lane); continue; } r -= 2 * I_2;
            if (r < I_CD) { transpose_item(in[22], 1024, 1536, WCD, 0, scr, r / 48, r % 48, lane); continue; } r -= I_CD;
            transpose_item(in[31], 512, 512, WGLU, 0, scr, r / 16, r % 16, lane);
        }
        }
        SEAM(1);
    }
    if (IN(2)) { for (int rep = 0; rep < REP_LN2; ++rep) ln_phase(in[0], in[2], nullptr, XC, MALL, nullptr, nullptr, MOD + 0 * 1024, MOD + 1 * 1024, H, gw, ngw, lane, MOD + 2 * 6144 + 2 * 1024, in[7]); SEAM(2); }
    if (IN(3)) {
        pg8::Gemm g{H, WIN0, MALL, 2816, D}; pg8::StaticOrder S; S.init(MALL, 2816, G, blk);
        pg8::EpiInL0 E{FG, Qb, Kb, Vt, ROPEC, ROPES, 0.125f * 1.4426950408889634f};
        for (int rep = 0; rep < REP_G3; ++rep)
        pg8::gemm_phase<pg8::EpiInL0, pg8::StaticOrder, true, true>(ldsp, g, S, E);
        SEAM(3);
    }
    if (IN(4)) {
        float lam;
        { const float d1 = wave_sum(in[17][lane] * in[18][lane]), d2 = wave_sum(in[19][lane] * in[20][lane]); lam = expf(d1) - expf(d2) + 0.2f; }
        const float* subg = in[21];
        const int nun = 768 + 24;
        for (int rep = 0; rep < REP_ATT; ++rep)
        for (int i = 0;; ++i) {
            int U;
            if (G == 256) { if (i < 3) U = (blk & 7) * 96 + (blk >> 3) + 32 * i; else { U = 768 + blk + (i - 3) * G; } }
            else U = blk + i * G;
            if (U >= nun) break;
            if (U < 768) { const int bh = U >> 6, qb = U & 63, b = bh / 6, hh = bh % 6; att::attn_unit<0>(lds, Qb, Kb, Vt, Y, b, hh, b * SEQ + qb * 128, NKEY, lam, subg, tid, wave, lane); }
            else { const int u2 = U - 768, b = u2 / 12, hh = (u2 / 2) % 6, qb = u2 & 1; att::attn_unit<0>(lds, Qb, Kb, Vt, Y, b, hh, MX + b * CTX + qb * 128, CTX, lam, subg, tid, wave, lane); }
        }
#if PROBE_ATT_VAR >= 0
        for (int i = 0; i < 3; ++i) {
            const int U = (G == 256) ? (blk & 7) * 96 + (blk >> 3) + 32 * i : blk + i * G; if (U >= 768) break;
            const int bh = U >> 6, qb = U & 63, b = bh / 6, hh = bh % 6;
            att::attn_unit<PROBE_ATT_VAR>(lds, Qb, Kb, Vt, (bf16*)(ws + WS_BIG + 108 * MiB), b, hh, b * SEQ + qb * 128, NKEY, lam, subg, tid, wave, lane, qb * 128);
        }
#endif
        for (int rep = 0; rep < REP_FFT; ++rep)
        for (int it = blk; it < 1024; it += G) {
            const int bg = (it >> 6) & 7, n2 = it & 63;
            if (it < 512) fft_step1<7>(lds, FG, TF, bg, bg & 3, (bg >> 2) * SEQ, n2, tid);
            else fft_step1<2>(lds, FG, TFC, bg, bg & 3, MX + (bg >> 2) * CTX, n2, tid);
        }
        SEAM(4);
    }
    if (IN(5)) {
        for (int rep = 0; rep < REP_FFT; ++rep)
        for (int it = blk; it < 1024 + 32; it += G) {
            if (it < 1024) { const int bg = it >> 7, k1 = it & 127; fft_step3(lds, TF, Y, bg, bg & 3, (bg >> 2) * SEQ, k1, 128, 0.0013810679320049757f, tid); }
            else { const int i2 = it - 1024, bg = i2 >> 2, k1 = i2 & 3; fft_step3(lds, TFC, Y, bg, bg & 3, MX + (bg >> 2) * CTX, k1, 4, 0.0078125f, tid); }
        }
        SEAM(5);
    }
    auto layer_tail = [&](auto LC) __attribute__((always_inline)) {
        constexpr int l = decltype(LC)::value;
        constexpr int pb = l == 0 ? 6 : 15;
        constexpr int M = l == 0 ? MALL : MX;
        const float* modl = MOD + (size_t)l * 3 * 6144;
        if constexpr (l == 1) {
            if (IN(11)) {
                pg8::Gemm g{H, WCD, MALL, 1536, D}; pg8::StaticOrder S; S.init(MALL, 1536, G, blk);
                pg8::EpiInL1 E{Sb, Ub, Vb};
                pg8::gemm_phase<pg8::EpiInL1, pg8::StaticOrder, true, true>(ldsp, g, S, E);
                SEAM(11);
            }
            if (IN(12)) {
                float* wl = (float*)lds + wave * 4096;
                for (int rep = 0; rep < REP_S5; ++rep)
                for (int it = gw; it < 2 * 32 * 2 * 66; it += ngw) s5_pass_a(wl, Sb, Eb, in, it, lane);
                __syncthreads();
                for (int rep = 0; rep < REP_GMLP; ++rep)
                for (int it = blk; it < 512; it += G) { const int g = it & 3, n = (it >> 2) & 63, b = it >> 8; gmlp_item(lds, Ub, Vb, in[33], in[34], Y, b, n, g, tid, wave, lane); }
                SEAM(12);
            }
            if (IN(13)) {
                float* wl = (float*)lds + wave * 4096;
                for (int rep = 0; rep < REP_S5; ++rep)
                for (int it = gw; it < 2 * 32 * 64; it += ngw) s5_pass_b(wl, Sb, Eb, GF, GA, in, it, lane);
                SEAM(13);
            }
            if (IN(14)) {
                pg8::Gemm g{GA, WGLU, MX, 512, 512}; pg8::StaticOrder S; S.init(MX, 512, G, blk);
                pg8::EpiGlu E{(const pg8::bf16_t*)GA, Y, in[32]};
                pg8::gemm_phase<pg8::EpiGlu, pg8::StaticOrder, true, true>(ldsp, g, S, E);
                SEAM(14);
            }
        }
        if (IN(pb)) {
            pg8::Gemm g{Y, WOUT + (size_t)l * D * D, M, D, D}; pg8::SplitOrder S; S.init(MX, D, D, G, blk, l == 0 ? 2 : 0, 8);
            pg8::EpiResGate E{l == 0 ? in[0] : XO, l == 0 ? in[2] : XC, XO, XC, modl + 2 * 1024, in[7] + l * D, ALPHA, (float*)(ws + WS_BIG), D / 8, l == 1 ? (const float*)(ws + WS_ST2) : nullptr, in[14], in[15]};
            pg8::gemm_phase<pg8::EpiResGate, pg8::SplitOrder, true, true>(ldsp, g, S, E);
            SEAM(pb);
        }
        if (IN(pb + 1)) { ln_phase(XO, XC, XO, XC, M, in[8] + l * D, in[9] + l * D, modl + 3 * 1024, modl + 4 * 1024, H, gw, ngw, lane, l == 0 ? modl + 2 * 6144 + 5 * 1024 : nullptr, in[13] + l * D, l == 0 ? (const float*)(ws + WS_BIG) : nullptr, 8, (float*)(ws + WS_ST1)); SEAM(pb + 1); }
        if (IN(pb + 2)) {
            pg8::Gemm g{H, W1 + (size_t)l * D * FF, M, FF, D}; pg8::StaticOrder S; S.init(M, FF, G, blk);
            pg8::EpiSqRelu E{ACT, FF, in[11] + l * FF};
            for (int rep = 0; rep < REP_FFN1; ++rep)
            pg8::gemm_phase<pg8::EpiSqRelu, pg8::StaticOrder, true, true>(ldsp, g, S, E);
            SEAM(pb + 2);
        }
        if (IN(pb + 3)) {
            pg8::Gemm g{ACT, W2 + (size_t)l * D * FF, M, D, FF}; pg8::SplitOrder S; S.init(MX, D, FF, G, blk, l == 0 ? 2 : 0, 16);
            pg8::EpiResGate E{XO, XC, XO, XC, modl + 5 * 1024, in[13] + l * D, ALPHA, (float*)(ws + WS_Y), FF / 16, (const float*)(ws + WS_ST1), in[8] + l * D, in[9] + l * D};
            pg8::gemm_phase<pg8::EpiResGate, pg8::SplitOrder, true, true>(ldsp, g, S, E);
            SEAM(pb + 3);
        }
        if (IN(pb + 4)) {
            if constexpr (l == 0) ln_phase(XO, XC, XO, XC, MALL, in[14], in[15], MOD + 3 * 6144 + 0 * 1024, MOD + 3 * 6144 + 1 * 1024, H, gw, ngw, lane, nullptr, nullptr, (const float*)(ws + WS_Y), 16, (float*)(ws + WS_ST2));
            else ln_phase(XO, XC, XO, XC, MX, in[14] + D, in[15] + D, nullptr, nullptr, nullptr, gw, ngw, lane);
            SEAM(pb + 4);
        }
    };
    layer_tail(std::integral_constant<int, 0>{});
    layer_tail(std::integral_constant<int, 1>{});
#undef IN
#undef SEAM
}

extern "C" void kernel_launch(void* const* d_in, const int* in_sizes, int n_in, void* d_out, int out_size, void* d_ws, size_t ws_size, hipStream_t stream) {
    static int grid = 0;
    if (grid == 0) {
        if (n_in != 35 || out_size != MX * D || ws_size < WS_END) { fprintf(stderr, "kernel_launch: unexpected problem shape (n_in %d out %d ws %zu)\n", n_in, out_size, ws_size); grid = -1; return; }
        int dev = 0, cus = 0, per_cu = 0;
        hipGetDevice(&dev); hipDeviceGetAttribute(&cus, hipDeviceAttributeMultiprocessorCount, dev);
        if (hipFuncSetAttribute((const void*)mega_fwd, hipFuncAttributeMaxDynamicSharedMemorySize, LDS_BYTES) != hipSuccess) { fprintf(stderr, "kernel_launch: hipFuncSetAttribute failed\n"); grid = -1; return; }
        if (hipOccupancyMaxActiveBlocksPerMultiprocessor(&per_cu, (const void*)mega_fwd, NTHR, LDS_BYTES) != hipSuccess || per_cu < 1) { fprintf(stderr, "kernel_launch: occupancy query says %d blocks/CU\n", per_cu); grid = -1; (void)hipGetLastError(); return; }
        grid = cus * 1;
    }
    if (grid < 0) return;
    Args a{};
    for (int i = 0; i < 35; ++i) a.in[i] = (const float*)d_in[i];
    a.out = (float*)d_out; a.ws = (unsigned char*)d_ws;
#if MK_MULTI
    for (int ph = 0; ph < N_PHASES; ++ph) { a.ph_lo = ph; a.ph_hi = ph + 1; hipLaunchKernelGGL(mega_fwd, dim3(grid), dim3(NTHR), LDS_BYTES, stream, a); }
#else
    if (hipMemsetAsync((char*)d_ws + WS_BAR, 0, XCD_BAR_WORDS * 4, stream) != hipSuccess) { fprintf(stderr, "kernel_launch: memset of the barrier words failed\n"); return; }
    a.ph_lo = 0; a.ph_hi = N_PHASES;
    void* kargs[] = {&a};
    hipError_t e = hipLaunchCooperativeKernel((const void*)mega_fwd, dim3(grid), dim3(NTHR), kargs, LDS_BYTES, stream);
    if (e != hipSuccess) fprintf(stderr, "kernel_launch: cooperative launch failed: %s (grid %d)\n", hipGetErrorString(e), grid);
#endif
}
```
